# Optimizing an MI355X kernel written in HIP

```python
import math
import jax, jax.numpy as jnp
from jax import lax
import numpy as np

D_MODEL = 2048
BATCH = 8
SEQ = 4096
DEPTH = 1
DEC_BATCH = 16
DEC_SEQ = 32
PAST_LEN = 4096

CHUNK = 64
N_PREV_CHUNKS = 8
BAND = (N_PREV_CHUNKS + 1) * CHUNK
HEAD_DIM = 128
N_HEADS_FOX = 8
N_HEADS_BAND = 8
D_FOX = N_HEADS_FOX * HEAD_DIM
D_BAND = N_HEADS_BAND * HEAD_DIM
D_FF = ((8 * D_MODEL + 3 * 256 - 1) // (3 * 256)) * 256
REL_CLIP = 128
Q_BLOCK = 128
FORGET_BIAS = 3.0
RMS_EPS = 1e-6
NEG_INF = -1e30
N_IN = 3 * D_FOX + N_HEADS_FOX + 3 * D_BAND + 2 * D_MODEL

kernel_name = "fox_chunkband_hybrid_stream_step"


def _rmsnorm(x, g):
    xf = x.astype(jnp.float32)
    y = xf * lax.rsqrt(jnp.mean(xf * xf, axis=-1, keepdims=True) + RMS_EPS)
    return (y * g.astype(jnp.float32)).astype(x.dtype)


def _mod_norm(x, g, shift, scale):
    return _rmsnorm(x, g) * (1.0 + scale[:, None, :]) + shift[:, None, :]


def _ada(c, w_ada, b_ada):
    m = jax.nn.silu(c) @ w_ada + b_ada
    return jnp.split(m, 6, axis=-1)


def _mixer_in(x, shift, scale, g, w_in, b_f):
    B, S, _ = x.shape
    h = _mod_norm(x, g, shift, scale)
    z = h @ w_in
    sizes = [D_FOX, D_FOX, D_FOX, N_HEADS_FOX, D_BAND, D_BAND, D_BAND, D_MODEL]
    cuts = [int(v) for v in np.cumsum(sizes)]
    qa, ka, va, fa, qb, kb, vb, za, zb = jnp.split(z, cuts, axis=-1)
    logf = jax.nn.log_sigmoid((fa + b_f).astype(jnp.float32))
    ha = lambda t: t.reshape(B, S, N_HEADS_FOX, HEAD_DIM)
    hb = lambda t: t.reshape(B, S, N_HEADS_BAND, HEAD_DIM)
    return ha(qa), ha(ka), ha(va), logf, hb(qb), hb(kb), hb(vb), za, zb


def _fox_prompt(q, k, v, logf):
    B, S, H, Dh = q.shape
    nb = S // Q_BLOCK
    Ft = jnp.cumsum(logf, axis=1).transpose(0, 2, 1)
    qb = q.reshape(B, nb, Q_BLOCK, H, Dh).transpose(1, 0, 2, 3, 4)
    Fq = Ft.reshape(B, H, nb, Q_BLOCK).transpose(2, 0, 1, 3)
    kpos = jnp.arange(S)
    inv = 1.0 / math.sqrt(Dh)

    def one_block(args):
        i, qi, fi = args
        s = jnp.einsum('bqhd,bkhd->bhqk', qi, k, preferred_element_type=jnp.float32) * inv
        s = s + fi[..., None] - Ft[:, :, None, :]
        qpos = i * Q_BLOCK + jnp.arange(Q_BLOCK)
        s = jnp.where(kpos[None, :] <= qpos[:, None], s, NEG_INF)
        p = jax.nn.softmax(s, axis=-1)
        return jnp.einsum('bhqk,bkhd->bqhd', p.astype(v.dtype), v)

    o = lax.map(one_block, (jnp.arange(nb), qb, Fq))
    return o.transpose(1, 0, 2, 3, 4).reshape(B, S, H * Dh)


def _fox_sample(q, k, v, logf, ck, cv, clogf):
    B, T, H, Dh = q.shape
    P = ck.shape[1]
    k_all = jnp.concatenate([ck, k], axis=1)
    v_all = jnp.concatenate([cv, v], axis=1)
    Ft = jnp.cumsum(jnp.concatenate([clogf.astype(jnp.float32), logf], axis=1), axis=1).transpose(0, 2, 1)
    s = jnp.einsum('bqhd,bkhd->bhqk', q, k_all, preferred_element_type=jnp.float32) / math.sqrt(Dh)
    s = s + Ft[:, :, P:, None] - Ft[:, :, None, :]
    mask = jnp.arange(P + T)[None, :] <= (P + jnp.arange(T))[:, None]
    s = jnp.where(mask, s, NEG_INF)
    p = jax.nn.softmax(s, axis=-1)
    return jnp.einsum('bhqk,bkhd->bqhd', p.astype(v_all.dtype), v_all).reshape(B, T, H * Dh)


def _rel_bias(table, rel):
    return table[jnp.clip(rel, -REL_CLIP, REL_CLIP) + REL_CLIP].transpose(2, 0, 1).astype(jnp.float32)


def _band_prompt(q, k, v, table):
    B, S, H, Dh = q.shape
    nc = S // CHUNK
    pad = N_PREV_CHUNKS * CHUNK
    kp = jnp.pad(k, ((0, 0), (pad, 0), (0, 0), (0, 0)))
    vp = jnp.pad(v, ((0, 0), (pad, 0), (0, 0), (0, 0)))
    qc = q.reshape(B, nc, CHUNK, H, Dh).transpose(1, 0, 2, 3, 4)
    rel = pad + jnp.arange(CHUNK)[:, None] - jnp.arange(BAND)[None, :]
    bias = _rel_bias(table, rel)
    inv = 1.0 / math.sqrt(Dh)

    def one_chunk(args):
        n, qn = args
        kn = lax.dynamic_slice_in_dim(kp, n * CHUNK, BAND, axis=1)
        vn = lax.dynamic_slice_in_dim(vp, n * CHUNK, BAND, axis=1)
        s = jnp.einsum('bqhd,bkhd->bhqk', qn, kn, preferred_element_type=jnp.float32) * inv + bias
        valid = (n - N_PREV_CHUNKS) * CHUNK + jnp.arange(BAND) >= 0
        s = jnp.where(valid[None, None, None, :], s, NEG_INF)
        p = jax.nn.softmax(s, axis=-1)
        return jnp.einsum('bhqk,bkhd->bqhd', p.astype(vn.dtype), vn)

    o = lax.map(one_chunk, (jnp.arange(nc), qc))
    return o.transpose(1, 0, 2, 3, 4).reshape(B, S, H * Dh)


def _band_sample(q, k, v, ck, cv, table):
    B, T, H, Dh = q.shape
    lb = ck.shape[1]
    k_all = jnp.concatenate([ck, k], axis=1)
    v_all = jnp.concatenate([cv, v], axis=1)
    rel = lb + jnp.arange(T)[:, None] - jnp.arange(lb + T)[None, :]
    s = jnp.einsum('bqhd,bkhd->bhqk', q, k_all, preferred_element_type=jnp.float32) / math.sqrt(Dh)
    s = s + _rel_bias(table, rel)
    p = jax.nn.softmax(s, axis=-1)
    return jnp.einsum('bhqk,bkhd->bqhd', p.astype(v_all.dtype), v_all).reshape(B, T, H * Dh)


def _merge(oa, ob, za, zb, w_oa, w_ob, w_out):
    m = jax.nn.sigmoid(za) * (oa @ w_oa) + jax.nn.sigmoid(zb) * (ob @ w_ob)
    return m @ w_out


def _swiglu(h, w_gate, w_up, w_down):
    return (jax.nn.silu(h @ w_gate) * (h @ w_up)) @ w_down


def _layer(x, c, attend, w_ada, b_ada, g_mix, w_in, b_f, w_oa, w_ob, w_out, g_ffn, w_gate, w_up, w_down):
    sh1, sc1, gt1, sh2, sc2, gt2 = _ada(c, w_ada, b_ada)
    qa, ka, va, lf, qb, kb, vb, za, zb = _mixer_in(x, sh1, sc1, g_mix, w_in, b_f)
    oa, ob = attend(qa, ka, va, lf, qb, kb, vb)
    x = x + gt1[:, None, :] * _merge(oa, ob, za, zb, w_oa, w_ob, w_out)
    x = x + gt2[:, None, :] * _swiglu(_mod_norm(x, g_ffn, sh2, sc2), w_gate, w_up, w_down)
    return x, ka, va, lf, kb, vb


def setup_inputs(seed: int = 0) -> dict:
    key = jax.random.key(seed)
    ks = jax.random.split(key, 24)
    f32 = jnp.float32
    nrm = lambda k, shape, s: s * jax.random.normal(k, shape, f32)
    lb = min(N_PREV_CHUNKS * CHUNK, PAST_LEN)
    return {
        "x_prompt": nrm(ks[0], (BATCH, SEQ, D_MODEL), 1.0),
        "x_sample": nrm(ks[1], (DEC_BATCH, DEC_SEQ, D_MODEL), 1.0),
        "cache_fox_k": nrm(ks[2], (DEPTH, DEC_BATCH, PAST_LEN, N_HEADS_FOX, HEAD_DIM), 1.0),
        "cache_fox_v": nrm(ks[3], (DEPTH, DEC_BATCH, PAST_LEN, N_HEADS_FOX, HEAD_DIM), 1.0),
        "cache_fox_logf": jax.nn.log_sigmoid(FORGET_BIAS + nrm(ks[4], (DEPTH, DEC_BATCH, PAST_LEN, N_HEADS_FOX), 1.0)),
        "cache_band_k": nrm(ks[5], (DEPTH, DEC_BATCH, lb, N_HEADS_BAND, HEAD_DIM), 1.0),
        "cache_band_v": nrm(ks[6], (DEPTH, DEC_BATCH, lb, N_HEADS_BAND, HEAD_DIM), 1.0),
        "c_prompt": nrm(ks[7], (BATCH, D_MODEL), 1.0),
        "c_sample": nrm(ks[8], (DEC_BATCH, D_MODEL), 1.0),
        "w_ada": nrm(ks[9], (DEPTH, D_MODEL, 6 * D_MODEL), 0.5 * D_MODEL ** -0.5),
        "b_ada": nrm(ks[10], (DEPTH, 6 * D_MODEL), 0.01),
        "g_mix": 1.0 + nrm(ks[11], (DEPTH, D_MODEL), 0.05),
        "w_in": nrm(ks[12], (DEPTH, D_MODEL, N_IN), D_MODEL ** -0.5),
        "b_f": FORGET_BIAS + nrm(ks[13], (DEPTH, N_HEADS_FOX), 0.1),
        "rel_bias": nrm(ks[14], (DEPTH, 2 * REL_CLIP + 1, N_HEADS_BAND), 0.1),
        "w_oa": nrm(ks[15], (DEPTH, D_FOX, D_MODEL), D_FOX ** -0.5),
        "w_ob": nrm(ks[16], (DEPTH, D_BAND, D_MODEL), D_BAND ** -0.5),
        "w_out": nrm(ks[17], (DEPTH, D_MODEL, D_MODEL), D_MODEL ** -0.5),
        "g_ffn": 1.0 + nrm(ks[18], (DEPTH, D_MODEL), 0.05),
        "w_gate": nrm(ks[19], (DEPTH, D_MODEL, D_FF), D_MODEL ** -0.5),
        "w_up": nrm(ks[20], (DEPTH, D_MODEL, D_FF), D_MODEL ** -0.5),
        "w_down": nrm(ks[21], (DEPTH, D_FF, D_MODEL), D_FF ** -0.5),
        "g_final": 1.0 + nrm(ks[22], (D_MODEL,), 0.05),
    }


def reference(x_prompt, x_sample, cache_fox_k, cache_fox_v, cache_fox_logf, cache_band_k, cache_band_v,
              c_prompt, c_sample, w_ada, b_ada, g_mix, w_in, b_f, rel_bias, w_oa, w_ob, w_out,
              g_ffn, w_gate, w_up, w_down, g_final):
    xp, xs = x_prompt, x_sample
    fk_p, fv_p, fl_p, bk_p, bv_p = [], [], [], [], []
    fk_s, fv_s, fl_s, bk_s, bv_s = [], [], [], [], []
    for l in range(DEPTH):
        params = (w_ada[l], b_ada[l], g_mix[l], w_in[l], b_f[l], w_oa[l], w_ob[l], w_out[l],
                  g_ffn[l], w_gate[l], w_up[l], w_down[l])
        tbl = rel_bias[l]
        attend_p = lambda qa, ka, va, lf, qb, kb, vb: (
            _fox_prompt(qa, ka, va, lf), _band_prompt(qb, kb, vb, tbl))
        xp, ka, va, lf, kb, vb = _layer(xp, c_prompt, attend_p, *params)
        lbp = min(N_PREV_CHUNKS * CHUNK, kb.shape[1])
        fk_p.append(ka); fv_p.append(va); fl_p.append(lf)
        bk_p.append(kb[:, -lbp:]); bv_p.append(vb[:, -lbp:])

        ck, cv, cl, cbk, cbv = cache_fox_k[l], cache_fox_v[l], cache_fox_logf[l], cache_band_k[l], cache_band_v[l]
        attend_s = lambda qa, ka, va, lf, qb, kb, vb: (
            _fox_sample(qa, ka, va, lf, ck, cv, cl), _band_sample(qb, kb, vb, cbk, cbv, tbl))
        xs, ka, va, lf, kb, vb = _layer(xs, c_sample, attend_s, *params)
        fk_s.append(ka); fv_s.append(va); fl_s.append(lf)
        bk_s.append(kb); bv_s.append(vb)

    y_prompt = _rmsnorm(xp, g_final)
    y_sample = _rmsnorm(xs, g_final)
    return (y_prompt, y_sample,
            jnp.stack(fk_p), jnp.stack(fv_p), jnp.stack(fl_p), jnp.stack(bk_p), jnp.stack(bv_p),
            jnp.stack(fk_s), jnp.stack(fv_s), jnp.stack(fl_s), jnp.stack(bk_s), jnp.stack(bv_s))
```

```cpp
#include <hip/hip_runtime.h>
#include <hip/hip_bf16.h>
#include <cstdio>
#include <cstdint>

#ifndef MK_N_LAUNCHES
#define MK_N_LAUNCHES 1
#endif

#ifndef REPEAT_MASK
#define REPEAT_MASK 0
#endif
#define NREP(k) (1 + ((REPEAT_MASK >> (k)) & 1))
#ifndef PROBE_PREFIX
#define PROBE_PREFIX -1
#endif
constexpr int DM = 2048, MP = 32768, MS = 512, MROWS = MP + MS, SEQ = 4096, NB_P = 8, NB_S = 16, TS = 32;
constexpr int NH = 8, HD = 128, DH = NH * HD  , DFF = 5632, NIN_SRC = 10248, NIN = 10240, NADA = 6 * DM;
constexpr int PAST = 4096, LBAND = 512;
constexpr float RMS_EPS = 1e-6f;
constexpr int NMT = MROWS / 256;
constexpr size_t O_YP = 0, O_YS = 67108864, O_FKP = 68157440, O_FVP = 101711872, O_FLP = 135266304, O_BKP = 135528448, O_BVP = 139722752,
                 O_FKS = 143917056, O_FVS = 144441344, O_FLS = 144965632, O_BKS = 144969728, O_BVS = 145494016, O_TOTAL = 146018304;
constexpr size_t MiB = 1u << 20;
constexpr size_t WS_CTL = 0, WS_MOD = 1 * MiB, ZERO_BYTES = 2 * MiB + 256 * 1024, WS_FNEG = 3 * MiB;
constexpr size_t WS_WIN = 8 * MiB, WS_WOA = 48 * MiB, WS_WOB = 52 * MiB, WS_WOUT = 56 * MiB, WS_WGU = 64 * MiB, WS_WDN = 108 * MiB;
constexpr size_t WS_H = 130 * MiB, WS_QKV = 260 * MiB, QKV_STRIDE_B = 65 * MiB, WS_ZA = 650 * MiB, WS_ZB = 780 * MiB, WS_H8 = 910 * MiB, WS_WIN8 = 975 * MiB, WS_END = 1000 * MiB;
constexpr size_t WS_SLAB4 = WS_QKV + QKV_STRIDE_B, WS_SLAB5 = WS_QKV, WS_SLAB8 = WS_ZA;
constexpr size_t _ws_slab_doc = 0;
constexpr size_t WS_M8 = WS_QKV + 2 * QKV_STRIDE_B;
constexpr size_t WS_ACT = WS_QKV, WS_T = WS_QKV + QKV_STRIDE_B;
constexpr size_t QKV_STRIDE = QKV_STRIDE_B / 2;
static_assert((size_t)MROWS * DH * 2 == QKV_STRIDE_B && (size_t)MROWS * DM * 2 == 130 * MiB && (size_t)MROWS * DFF * 2 <= 6 * QKV_STRIDE_B, "ws map");
constexpr int FNEG_LD = 4160;
constexpr int CW_TMO = 0, CW_BAR = 4096, CW_Q = 8192;
constexpr int NWAVES = 8, NTHREADS = 512;
constexpr int RING_BYTES = 131072, LDSCTL_OFF = RING_BYTES, MISC_OFF = LDSCTL_OFF + 320, LDS_BYTES = 147456;

#define GAS __attribute__((address_space(1)))
#define LAS __attribute__((address_space(3)))
typedef unsigned short bf16;
typedef unsigned v4u __attribute__((ext_vector_type(4)));
typedef float f32x4 __attribute__((ext_vector_type(4)));
typedef float f32x2 __attribute__((ext_vector_type(2)));
typedef float f32x16 __attribute__((ext_vector_type(16)));
typedef short bf16x8 __attribute__((ext_vector_type(8)));
typedef short s16x4 __attribute__((ext_vector_type(4)));
typedef unsigned u32x4 __attribute__((ext_vector_type(4)));
typedef unsigned u32x2 __attribute__((ext_vector_type(2)));
typedef GAS unsigned gu32;
#define RLX_AGENT __ATOMIC_RELAXED, __HIP_MEMORY_SCOPE_AGENT
#define LDS_WAIT() asm volatile("s_waitcnt lgkmcnt(0)" ::: "memory")
#define VM_WAIT() asm volatile("s_waitcnt vmcnt(0)" ::: "memory")

__device__ __forceinline__ unsigned cvt_pk_bf16(float lo, float hi) { unsigned r; asm volatile("s_nop 1\n\tv_cvt_pk_bf16_f32 %0, %1, %2" : "=v"(r) : "v"(lo), "v"(hi)); return r; }
__device__ __forceinline__ float fp8_clamp(float x) { return __builtin_amdgcn_fmed3f(x, -448.0f, 448.0f); }
__device__ __forceinline__ unsigned cvt_pk4_fp8(float a, float b, float c, float d) { int w = __builtin_amdgcn_cvt_pk_fp8_f32(fp8_clamp(a), fp8_clamp(b), 0, false); w = __builtin_amdgcn_cvt_pk_fp8_f32(fp8_clamp(c), fp8_clamp(d), w, true); return (unsigned)w; }
constexpr float H_SCALE = 8.0f, WIN_SCALE = 32.0f;
constexpr float O_SCALE = 16.0f, WO_SCALE = 16.0f;
constexpr float G_SCALE = 256.0f;
__device__ __forceinline__ void fp8x8_to_f32(u32x2 w, f32x4& lo, f32x4& hi) {
    typedef float f32x2_ __attribute__((ext_vector_type(2)));
    const f32x2_ a = __builtin_amdgcn_cvt_pk_f32_fp8((int)w.x, false), b = __builtin_amdgcn_cvt_pk_f32_fp8((int)w.x, true);
    const f32x2_ c = __builtin_amdgcn_cvt_pk_f32_fp8((int)w.y, false), d = __builtin_amdgcn_cvt_pk_f32_fp8((int)w.y, true);
    lo = (f32x4){a.x, a.y, b.x, b.y}; hi = (f32x4){c.x, c.y, d.x, d.y};
}
constexpr float WOUT_SCALE = 32.0f, M_SCALE = 16.0f;
constexpr float WDN_SCALE = 64.0f;
__device__ __forceinline__ float bf_lo(unsigned w) { return __uint_as_float(w << 16); }
__device__ __forceinline__ float bf_hi(unsigned w) { return __uint_as_float(w & 0xffff0000u); }
__device__ __forceinline__ float sigmoid_f(float v) { return __builtin_amdgcn_rcpf(1.0f + __builtin_amdgcn_exp2f(-1.4426950408889634f * v)); }
__device__ __forceinline__ int lane_id() { int l; asm volatile("v_mbcnt_lo_u32_b32 %0, -1, 0\n\tv_mbcnt_hi_u32_b32 %0, -1, %0" : "=v"(l)); return l; }
template <class T> __device__ __forceinline__ T* uni_ptr(T* p) {
    const unsigned long long v = (unsigned long long)p; const unsigned lo = __builtin_amdgcn_readfirstlane((unsigned)v), hi = __builtin_amdgcn_readfirstlane((unsigned)(v >> 32));
    return (T*)(((unsigned long long)hi << 32) | lo); }
__device__ __forceinline__ float wave_sum(float v) {
#pragma unroll
    for (int o = 1; o < 64; o <<= 1) v += __shfl_xor(v, o);
    return v;
}

namespace pg8 {
typedef unsigned short bf16_t;
constexpr int BM = 256, BK = 64, HALF = 128, HTB = HALF * BK * 2, STAGE_BYTES = 8 * HTB, NXCD = 8, WGM = 4;
__host__ __device__ __forceinline__ int lds_byte(int r, int c) { const int st = (r >> 4) * 2 + (c >> 5), rr = r & 15, cc = c & 31, ob = rr * 64 + cc * 2; return st * 1024 + (ob ^ (((ob >> 9) & 1) << 5)); }
__host__ __device__ __forceinline__ void stage_rc(int b, int& R, int& C) { const int st = b / 1024, sb = b % 1024, swz = sb ^ (((sb >> 9) & 1) << 5); R = (st >> 1) * 16 + swz / 64; C = (st & 1) * 32 + (swz % 64) / 2; }
__host__ __device__ __forceinline__ int perm32(int rho) { const int n = rho >> 4, i = rho & 15; return 8 * (i >> 2) + 4 * n + (i & 3); }

struct Unit { int pm, pn, sub, kt0, nkt, part; };
struct Gemm { const bf16_t* A; const bf16_t* Bt; const bf16_t* A2; const bf16_t* Bt2; int K; };

struct StaticOrder {
    int nM, nN, nwg, G, c, pair, nkt_full, nmini, nsplit, mini_nkt, mini_pm0, mini_pair, skew = 0, nfull = 0;
    __device__ void init(int nM_, int nN_, int G_, int c_, int pair_, int nkt_full_, int nmini_ = 0, int nsplit_ = 1, int mini_nkt_ = 0, int mini_pm0_ = 0, int mini_pair_ = 0) {
        mini_pair = mini_pair_; nM = nM_; nN = nN_; nwg = nM * nN; G = G_; c = c_; pair = pair_; nkt_full = nkt_full_; nmini = nmini_; nsplit = nsplit_; mini_nkt = mini_nkt_; mini_pm0 = mini_pm0_; }
    __device__ __forceinline__ bool next(int i, Unit& u) const {
        const bool hm = c < nmini, mini = hm && i == 0;
        int j = i - (hm ? 1 : 0); j = j < 0 ? 0 : j;
        const int ip = j >> pair;
        const bool sk = skew > 0 && ip >= nfull;
        const long L = sk ? (long)nfull * G + (long)(ip - nfull) * (G - skew) + (c - skew) : (long)ip * G + c; const bool ok = L < nwg && (!sk || c >= skew);
        int wgid = ok ? (int)L : 0; { const int q = nwg / NXCD, r = nwg % NXCD, xcd = wgid % NXCD, off = wgid / NXCD; wgid = (xcd < r ? xcd * (q + 1) : r * (q + 1) + (xcd - r) * q) + off; }
        const int nig = WGM * nN, gid = wgid / nig, fm = gid * WGM, gsz = (nM - fm) < WGM ? (nM - fm) : WGM;
        const int fpm = fm + ((wgid % nig) % gsz), fpn = (wgid % nig) / gsz;
        const int ns = nsplit > 0 ? nsplit : 1, t = c / ns, ks = c - t * ns, mpm = mini_pm0 + t / nN, mpn = t % nN;
        u.pm = __builtin_amdgcn_readfirstlane(mini ? mpm : fpm); u.pn = __builtin_amdgcn_readfirstlane(mini ? mpn : fpn);
        const int kh = mini_pair ? ns / 2 : ns, msub = mini_pair ? ks / kh : 0, mk = ks - msub * kh;
        u.sub = __builtin_amdgcn_readfirstlane(mini ? msub : (j & ((1 << pair) - 1))); u.kt0 = __builtin_amdgcn_readfirstlane(mini ? mk * mini_nkt : 0); u.nkt = mini ? mini_nkt : nkt_full; u.part = mini ? 1 + ks : 0;
        return mini || ok;
    }
};

typedef f32x4 Acc[2][2][4][2];

template <bool F8> struct EpiInProj {
    static constexpr bool PERM = true;
    static __device__ __forceinline__ int mapn(int pn) { return F8 ? pn + (pn >= 4 ? 8 : 0) + (pn >= 8 ? 8 : 0) : pn + 4 + (pn >= 8 ? 4 : 0); }
    static __device__ __forceinline__ bool keep(const Unit&) { return false; }
    bf16_t* qkv; bf16_t* za; bf16_t* zb; float* out;
    __device__ __forceinline__ void operator()(const Acc& acc, const Unit& u, int wr, int wc, int fr, int fq) const {
        const int pn = u.pn, pm = u.pm; const int rloc = wr * 64 + fr;
        constexpr float QS = F8 ? 1.0f / (H_SCALE * WIN_SCALE) : 1.0f;
        if (!F8 || pn < 24) {
            const int reg = pn >> 2, colt = (pn & 3) * 256 + wc * 32 + 8 * fq;
            bf16_t* base = qkv + (size_t)reg * QKV_STRIDE + (size_t)(pm * 256 + rloc) * DH + colt;
            float* fo = nullptr;
            if (!F8 && (reg == 1 || reg == 2 || reg == 4 || reg == 5)) {
                if (pm < 128) {
                    if (reg == 1) fo = out + O_FKP + (size_t)(pm * 256) * DH;
                    else if (reg == 2) fo = out + O_FVP + (size_t)(pm * 256) * DH;
                    else if ((pm & 15) >= 14) fo = out + (reg == 4 ? O_BKP : O_BVP) + ((size_t)(pm >> 4) * LBAND + (size_t)((pm & 15) - 14) * 256) * DH;
                } else {
                    const size_t ms0 = (size_t)(pm - 128) * 256 * DH;
                    fo = out + (reg == 1 ? O_FKS : reg == 2 ? O_FVS : reg == 4 ? O_BKS : O_BVS) + ms0;
                }
                if (fo) fo += (size_t)rloc * DH + colt;
            }
#pragma unroll
            for (int ai = 0; ai < 2; ++ai)
#pragma unroll
                for (int m = 0; m < 4; ++m) {
                    const size_t ro = (size_t)(ai * HALF + m * 16) * DH;
#pragma unroll
                    for (int bj = 0; bj < 2; ++bj) {
                        const f32x4 v0 = acc[ai][bj][m][0] * QS, v1 = acc[ai][bj][m][1] * QS;
                        u32x4 w; w.x = cvt_pk_bf16(v0[0], v0[1]); w.y = cvt_pk_bf16(v0[2], v0[3]); w.z = cvt_pk_bf16(v1[0], v1[1]); w.w = cvt_pk_bf16(v1[2], v1[3]);
                        *(u32x4*)(base + ro + bj * HALF) = w;
                        if (!F8 && fo) { *(f32x4*)(fo + ro + bj * HALF) = v0; *(f32x4*)(fo + ro + bj * HALF + 4) = v1; }
                    }
                }
        } else {
            unsigned char* base = (unsigned char*)(pn < 32 ? za : zb) + (size_t)(pm * 256 + rloc) * DM + ((pn - 24) & 7) * 256 + wc * 32 + 8 * fq;
#pragma unroll
            for (int ai = 0; ai < 2; ++ai)
#pragma unroll
                for (int m = 0; m < 4; ++m) {
                    const size_t ro = (size_t)(ai * HALF + m * 16) * DM;
#pragma unroll
                    for (int bj = 0; bj < 2; ++bj) {
                        const f32x4 v0 = acc[ai][bj][m][0] * QS, v1 = acc[ai][bj][m][1] * QS;
                        u32x2 w; w.x = cvt_pk4_fp8(sigmoid_f(v0[0]) * G_SCALE, sigmoid_f(v0[1]) * G_SCALE, sigmoid_f(v0[2]) * G_SCALE, sigmoid_f(v0[3]) * G_SCALE);
                        w.y = cvt_pk4_fp8(sigmoid_f(v1[0]) * G_SCALE, sigmoid_f(v1[1]) * G_SCALE, sigmoid_f(v1[2]) * G_SCALE, sigmoid_f(v1[3]) * G_SCALE);
                        *(u32x2*)(base + ro + bj * HALF) = w;
                    }
                }
        }
    }
};
struct EpiMerge {
    static constexpr bool PERM = true;
    static __device__ __forceinline__ int mapn(int pn) { return pn; }
    static __device__ __forceinline__ bool keep(const Unit& u) { return u.sub == 0 && u.part == 0; }
    bf16_t* za; const bf16_t* zb; float* slab; unsigned char* m8;
    __device__ __forceinline__ void operator()(Acc& acc, const Unit& u, int wr, int wc, int fr, int fq) const {
        if (u.part) {
            const unsigned char* sg = (const unsigned char*)(u.sub == 0 ? (const bf16_t*)za : zb) + (size_t)(u.pm * 256 + wr * 64 + fr) * DM + u.pn * 256 + wc * 32 + 8 * fq;
            float* sl = slab + ((size_t)(u.part - 1) * MS + (u.pm * 256 - MP) + wr * 64 + fr) * DM + u.pn * 256 + wc * 32 + 8 * fq;
#pragma unroll
            for (int ai = 0; ai < 2; ++ai)
#pragma unroll
                for (int m = 0; m < 4; ++m)
#pragma unroll
                    for (int bj = 0; bj < 2; ++bj) { const size_t ro = (size_t)(ai * HALF + m * 16) * DM + bj * HALF;
                        f32x4 g0, g1; fp8x8_to_f32(*(const u32x2*)(sg + ro), g0, g1);
                        *(f32x4*)(sl + ro) = acc[ai][bj][m][0] * (1.0f / (O_SCALE * WO_SCALE * G_SCALE)) * g0;
                        *(f32x4*)(sl + ro + 4) = acc[ai][bj][m][1] * (1.0f / (O_SCALE * WO_SCALE * G_SCALE)) * g1; }
            return;
        }
        const unsigned loff = (unsigned)((wr * 64 + fr) * DM + wc * 32 + 8 * fq);
        const size_t ub = (size_t)(u.pm * 256) * DM + u.pn * 256;
        const char* zb_ = uni_ptr((const char*)zb + ub); char* za_ = uni_ptr((char*)za + ub); char* m8_ = uni_ptr((char*)m8 + ub);
        asm volatile("" : "+s"(zb_), "+s"(za_), "+s"(m8_));
        const GAS char* zbp = (const GAS char*)zb_; GAS char* zap = (GAS char*)za_; GAS char* m8p = (GAS char*)m8_;
        u32x2 sa[4][2], sb[4][2];
#define EM_LOAD(ai_, m_, bj_) do { const unsigned ro_ = (unsigned)(((ai_) * HALF + (m_) * 16) * DM + (bj_) * HALF); \
            sb[m_][bj_] = *(const GAS u32x2*)(zbp + ro_ + loff); if (u.sub == 0) sa[m_][bj_] = *(const GAS u32x2*)(zap + ro_ + loff); } while (0)
#pragma unroll
        for (int m = 0; m < 4; ++m)
#pragma unroll
            for (int bj = 0; bj < 2; ++bj) EM_LOAD(0, m, bj);
#pragma unroll
        for (int ai = 0; ai < 2; ++ai) {
#pragma unroll
            for (int m = 0; m < 4; ++m)
#pragma unroll
                for (int bj = 0; bj < 2; ++bj) { const unsigned ro = (unsigned)((ai * HALF + m * 16) * DM + bj * HALF);
                    f32x4 b0, b1; fp8x8_to_f32(sb[m][bj], b0, b1);
                    if (u.sub == 0) {
                        f32x4 a0, a1; fp8x8_to_f32(sa[m][bj], a0, a1);
#pragma unroll
                        for (int e = 0; e < 4; ++e) { acc[ai][bj][m][0][e] *= a0[e] * __builtin_amdgcn_rcpf(fmaxf(b0[e], 1e-30f)); acc[ai][bj][m][1][e] *= a1[e] * __builtin_amdgcn_rcpf(fmaxf(b1[e], 1e-30f)); } }
                    else {
                        const f32x4 v0 = acc[ai][bj][m][0] * b0 * (M_SCALE / (O_SCALE * WO_SCALE * G_SCALE)), v1 = acc[ai][bj][m][1] * b1 * (M_SCALE / (O_SCALE * WO_SCALE * G_SCALE));
                        u32x2 w8; w8.x = cvt_pk4_fp8(v0[0], v0[1], v0[2], v0[3]); w8.y = cvt_pk4_fp8(v1[0], v1[1], v1[2], v1[3]);
                        *(GAS u32x2*)(m8p + ro + loff) = w8; }
                    if (ai == 0) EM_LOAD(1, m, bj); }
        }
#undef EM_LOAD
    }
};
template <bool SRC_F32> struct EpiResid {
    static constexpr bool PERM = true;
    static __device__ __forceinline__ int mapn(int pn) { return pn; }
    static __device__ __forceinline__ bool keep(const Unit&) { return false; }
    const float* xf; bf16_t* xb; const float* gate; float* slab;
    __device__ __forceinline__ void operator()(const Acc& acc, const Unit& u, int wr, int wc, int fr, int fq) const {
        const int col0 = u.pn * 256 + wc * 32 + 8 * fq;
        if (u.part) {
            const int ks = u.part - 1, rs0 = u.pm * 256 - MP;
            char* sl_ = uni_ptr((char*)(slab + ((size_t)ks * MS + rs0) * DM + u.pn * 256));
            asm volatile("" : "+s"(sl_));
            GAS char* sl = (GAS char*)sl_;
            const unsigned lo4 = (unsigned)((wr * 64 + fr) * DM + wc * 32 + 8 * fq) * 4u;
#pragma unroll
            for (int ai = 0; ai < 2; ++ai)
#pragma unroll
                for (int m = 0; m < 4; ++m) {
                    const int gi = NB_P + ((rs0 + ai * HALF + wr * 64) >> 5) + (m >> 1);
                    const float* grow = gate + (size_t)gi * NADA + col0;
#pragma unroll
                    for (int bj = 0; bj < 2; ++bj)
#pragma unroll
                        for (int n = 0; n < 2; ++n) { const int co = bj * HALF + n * 4;
                            *(GAS f32x4*)(sl + (unsigned)((ai * HALF + m * 16) * DM + co) * 4u + lo4) = *(const f32x4*)(grow + co) * acc[ai][bj][m][n] * (SRC_F32 ? 1.0f / (WOUT_SCALE * M_SCALE) : 1.0f / WDN_SCALE); }
                }
            return;
        }
        const unsigned lofe = (unsigned)((wr * 64 + fr) * DM + wc * 32 + 8 * fq), lo4 = lofe * 4u, lo2 = lofe * 2u;
        const size_t ube = (size_t)(u.pm * 256) * DM + u.pn * 256;
        const char* xs_ = uni_ptr((const char*)xf + ube * 4); char* bs_ = uni_ptr((char*)xb + ube * 2); const float* gs_ = gate + (size_t)(u.pm >> 4) * NADA + col0;
        asm volatile("" : "+s"(xs_), "+s"(bs_));
        const GAS char* xs = (const GAS char*)xs_; GAS char* bs = (GAS char*)bs_;
        f32x4 g[2][2];
#pragma unroll
        for (int bj = 0; bj < 2; ++bj)
#pragma unroll
            for (int n = 0; n < 2; ++n) g[bj][n] = *(const f32x4*)(gs_ + bj * HALF + n * 4) * (SRC_F32 ? 1.0f / (WOUT_SCALE * M_SCALE) : 1.0f / WDN_SCALE);
        f32x4 x[4][2][2]; u32x4 xw[4][2];
#define ER_LOAD(ai_, m_, bj_) do { const size_t eo_ = (size_t)((ai_) * HALF + (m_) * 16) * DM + (bj_) * HALF; \
            if constexpr (SRC_F32) { x[m_][bj_][0] = *(const GAS f32x4*)(xs + eo_ * 4 + lo4); x[m_][bj_][1] = *(const GAS f32x4*)(xs + eo_ * 4 + 16 + lo4); } \
            else xw[m_][bj_] = *(const GAS u32x4*)(bs + eo_ * 2 + lo2); } while (0)
#pragma unroll
        for (int m = 0; m < 4; ++m)
#pragma unroll
            for (int bj = 0; bj < 2; ++bj) ER_LOAD(0, m, bj);
#pragma unroll
        for (int ai = 0; ai < 2; ++ai) {
#pragma unroll
            for (int m = 0; m < 4; ++m)
#pragma unroll
                for (int bj = 0; bj < 2; ++bj) { const size_t eo = (size_t)(ai * HALF + m * 16) * DM + bj * HALF;
                    f32x4 x0, x1;
                    if constexpr (SRC_F32) { x0 = x[m][bj][0]; x1 = x[m][bj][1]; }
                    else { const u32x4 w = xw[m][bj]; x0 = (f32x4){bf_lo(w.x), bf_hi(w.x), bf_lo(w.y), bf_hi(w.y)}; x1 = (f32x4){bf_lo(w.z), bf_hi(w.z), bf_lo(w.w), bf_hi(w.w)}; }
                    x0 += g[bj][0] * acc[ai][bj][m][0]; x1 += g[bj][1] * acc[ai][bj][m][1];
                    u32x4 o; o.x = cvt_pk_bf16(x0[0], x0[1]); o.y = cvt_pk_bf16(x0[2], x0[3]); o.z = cvt_pk_bf16(x1[0], x1[1]); o.w = cvt_pk_bf16(x1[2], x1[3]);
                    *(GAS u32x4*)(bs + eo * 2 + lo2) = o;
                    if (ai == 0) ER_LOAD(1, m, bj); }
        }
#undef ER_LOAD
    }
};
struct EpiSwiglu {
    static constexpr bool PERM = true;
    static __device__ __forceinline__ int mapn(int pn) { return pn; }
    static __device__ __forceinline__ bool keep(const Unit&) { return false; }
    bf16_t* act;
    __device__ __forceinline__ void operator()(const Acc& acc, const Unit& u, int wr, int wc, int fr, int fq) const {
        unsigned char* base = (unsigned char*)act + (size_t)(u.pm * 256 + wr * 64 + fr) * DFF + u.pn * 128 + wc * 32 + 8 * fq;
#pragma unroll
        for (int ai = 0; ai < 2; ++ai)
#pragma unroll
            for (int m = 0; m < 4; ++m) {
                const f32x4 g0 = acc[ai][0][m][0], g1 = acc[ai][0][m][1], u0 = acc[ai][1][m][0], u1 = acc[ai][1][m][1];
                float a[8];
#pragma unroll
                for (int e = 0; e < 4; ++e) { a[e] = g0[e] * sigmoid_f(g0[e]) * u0[e]; a[4 + e] = g1[e] * sigmoid_f(g1[e]) * u1[e]; }
                u32x2 w; w.x = cvt_pk4_fp8(a[0], a[1], a[2], a[3]); w.y = cvt_pk4_fp8(a[4], a[5], a[6], a[7]);
                *(u32x2*)(base + (size_t)(ai * HALF + m * 16) * DFF) = w;
            }
    }
};

typedef int v8i32 __attribute__((ext_vector_type(8))); typedef int v4i32 __attribute__((ext_vector_type(4))); typedef float f32x8 __attribute__((ext_vector_type(8)));
__device__ __forceinline__ v8i32 cat8(bf16x8 lo, bf16x8 hi) { return __builtin_shufflevector(__builtin_bit_cast(v4i32, lo), __builtin_bit_cast(v4i32, hi), 0, 1, 2, 3, 4, 5, 6, 7); }
template <class Epi, bool ALIGN_EPI = true, bool FP8 = false>
__device__ __forceinline__ void gemm_phase(LAS unsigned char* lds, const Gemm g, const StaticOrder& S, const Epi& E, const int wid) {
    const int lane = lane_id(), tid = wid * 64 + lane, wr = wid >> 2, wc = wid & 3, fr = lane & 15, fq = lane >> 4;
    const int K = g.K;
    unsigned voffA[2], voffB[2];
#pragma unroll
    for (int i = 0; i < 2; ++i) { int R, C; stage_rc(tid * 16 + i * 8192, R, C); const int Rb = Epi::PERM ? ((R & ~31) + perm32(R & 31)) : R;
        const unsigned rpb = FP8 ? (unsigned)K : 2u * (unsigned)K;
        voffA[i] = (unsigned)R * rpb + (unsigned)C * 2u; voffB[i] = (unsigned)Rb * rpb + (unsigned)C * 2u; }
    const size_t kstep = (size_t)(BK * 2);
    const size_t hstep = (size_t)HALF * K * (FP8 ? 1 : 2);
    const size_t tstep = 2 * hstep;
    const unsigned ldsw = (unsigned)wid * 1024u;
    const int aoff = lds_byte(wr * 64 + fr, fq * 8);
    const int boff = lds_byte(wc * 32 + fr, fq * 8);
    constexpr int KOFF = 1024;
#define PG8_SA(b, h) (((b) * 2 + (h)) * HTB)
#define PG8_SB(b, h) ((4 + (b) * 2 + (h)) * HTB)
#define PG8_STAGE(bufoff, gbase, voff) do { _Pragma("unroll") for (int _i = 0; _i < 2; ++_i) \
        __builtin_amdgcn_global_load_lds((const unsigned*)((const char*)(gbase) + (voff)[_i]), (LAS unsigned*)(lds + (bufoff) + ldsw + _i * 8192), 16, 0, 0); } while (0)
#define PG8_LDA(dst, b, h) do { _Pragma("unroll") for (int m = 0; m < 4; ++m) _Pragma("unroll") for (int k = 0; k < 2; ++k) dst[m][k] = *(const LAS bf16x8*)(lds + PG8_SA(b, h) + aoff + m * 2048 + k * KOFF); } while (0)
#define PG8_LDB(dst, b, h) do { _Pragma("unroll") for (int n = 0; n < 2; ++n) _Pragma("unroll") for (int k = 0; k < 2; ++k) dst[n][k] = *(const LAS bf16x8*)(lds + PG8_SB(b, h) + boff + n * 2048 + k * KOFF); } while (0)
#define PG8_MMA(ai, bj, At, Bt) do { __builtin_amdgcn_s_setprio(1); _Pragma("unroll") for (int m = 0; m < 4; ++m) { \
        if constexpr (FP8) { const f32x8 c_ = acc8[ai][bj][m]; const v8i32 a_ = cat8(At[m][0], At[m][1]); \
            const f32x4 lo_ = __builtin_amdgcn_mfma_scale_f32_16x16x128_f8f6f4(cat8(Bt[0][0], Bt[0][1]), a_, __builtin_shufflevector(c_, c_, 0, 1, 2, 3), 0, 0, 0, 0x7F7F7F7F, 0, 0x7F7F7F7F); \
            const f32x4 hi_ = __builtin_amdgcn_mfma_scale_f32_16x16x128_f8f6f4(cat8(Bt[1][0], Bt[1][1]), a_, __builtin_shufflevector(c_, c_, 4, 5, 6, 7), 0, 0, 0, 0x7F7F7F7F, 0, 0x7F7F7F7F); \
            acc8[ai][bj][m] = __builtin_shufflevector(lo_, hi_, 0, 1, 2, 3, 4, 5, 6, 7); } \
        else { _Pragma("unroll") for (int n = 0; n < 2; ++n) _Pragma("unroll") for (int k = 0; k < 2; ++k) acc[ai][bj][m][n] = __builtin_amdgcn_mfma_f32_16x16x32_bf16(Bt[n][k], At[m][k], acc[ai][bj][m][n], 0, 0, 0); } } \
        __builtin_amdgcn_s_setprio(0); } while (0)
#define PG8_WAIT_V(n) asm volatile("s_waitcnt vmcnt(" #n ")" ::: "memory")
#define PG8_WAIT_L(n) asm volatile("s_waitcnt lgkmcnt(" #n ")" ::: "memory")
#define PG8_BAR __builtin_amdgcn_s_barrier()
#define PG8_SCHED __builtin_amdgcn_sched_barrier(0)
#define PG8_UA(u) ((const char*)((u).sub ? g.A2 : g.A) + (size_t)(u).pm * tstep + (size_t)(u).kt0 * kstep)
#define PG8_UB(u) ((const char*)((u).sub ? g.Bt2 : g.Bt) + (size_t)(u).pn * tstep + (size_t)(u).kt0 * kstep)
    Unit cur, nxt; int ui = 0;
    if (!S.next(0, cur)) return;
    cur.pn = Epi::mapn(cur.pn);
    Acc acc;
#pragma unroll
    for (int a = 0; a < 2; ++a)
#pragma unroll
        for (int b = 0; b < 2; ++b)
#pragma unroll
            for (int m = 0; m < 4; ++m)
#pragma unroll
                for (int n = 0; n < 2; ++n) acc[a][b][m][n] = (f32x4){0.f, 0.f, 0.f, 0.f};
    f32x8 acc8[2][2][4];
#pragma unroll
    for (int a = 0; a < 2; ++a)
#pragma unroll
        for (int b = 0; b < 2; ++b)
#pragma unroll
            for (int m = 0; m < 4; ++m) acc8[a][b][m] = (f32x8){0.f, 0.f, 0.f, 0.f, 0.f, 0.f, 0.f, 0.f};
    bf16x8 At[4][2], B0[2][2], B1[2][2];
    const char* cA = PG8_UA(cur); const char* cB = PG8_UB(cur);
    PG8_STAGE(PG8_SB(0, 0), cB, voffB); PG8_STAGE(PG8_SB(0, 1), cB + hstep, voffB); PG8_STAGE(PG8_SA(0, 0), cA, voffA); PG8_STAGE(PG8_SA(0, 1), cA + hstep, voffA);
    if (wr == 1) PG8_BAR;
    PG8_WAIT_V(2); PG8_BAR;
    PG8_STAGE(PG8_SB(1, 0), cB + kstep, voffB); PG8_STAGE(PG8_SA(1, 0), cA + kstep, voffA); PG8_STAGE(PG8_SB(1, 1), cB + hstep + kstep, voffB);
    PG8_WAIT_V(6); PG8_BAR;
    for (;;) {
        const bool has_next = S.next(ui + 1, nxt);
        nxt.pn = Epi::mapn(nxt.pn);
        const char* nA = has_next ? PG8_UA(nxt) : cA; const char* nB = has_next ? PG8_UB(nxt) : cB;
        const int nt = cur.nkt;
        for (int t = 0; t < nt; t += 2) {
            const bool last = (t == nt - 2);
            if constexpr (FP8) {
#pragma unroll
                for (int a = 0; a < 2; ++a)
#pragma unroll
                    for (int b = 0; b < 2; ++b)
#pragma unroll
                        for (int m = 0; m < 4; ++m) asm volatile("" : "+v"(acc8[a][b][m]));
            }
            const char* a1 = cA + (size_t)(t + 1) * kstep;
            const char* a2 = last ? nA : cA + (size_t)(t + 2) * kstep; const char* b2 = last ? nB : cB + (size_t)(t + 2) * kstep;
            const char* a3 = a2 + kstep; const char* b3 = b2 + kstep;
            PG8_LDB(B0, 0, 0); PG8_LDB(B1, 0, 1); PG8_SCHED; PG8_LDA(At, 0, 0); PG8_STAGE(PG8_SA(1, 1), a1 + hstep, voffA);
            PG8_WAIT_V(8); PG8_WAIT_L(0); PG8_BAR; PG8_MMA(0, 0, At, B0); PG8_MMA(0, 1, At, B1); PG8_BAR; PG8_SCHED;
            PG8_LDA(At, 0, 1); PG8_STAGE(PG8_SB(0, 0), b2, voffB); PG8_STAGE(PG8_SB(0, 1), b2 + hstep, voffB); PG8_STAGE(PG8_SA(0, 0), a2, voffA);
            PG8_WAIT_V(8); PG8_WAIT_L(0); PG8_BAR; PG8_MMA(1, 0, At, B0); PG8_MMA(1, 1, At, B1); PG8_BAR; PG8_SCHED;
            PG8_LDB(B0, 1, 0); PG8_LDB(B1, 1, 1); PG8_SCHED; PG8_LDA(At, 1, 0); PG8_STAGE(PG8_SA(0, 1), a2 + hstep, voffA);
            PG8_WAIT_V(8); PG8_WAIT_L(0); PG8_BAR; PG8_MMA(0, 0, At, B0); PG8_MMA(0, 1, At, B1); PG8_BAR; PG8_SCHED;
            PG8_LDA(At, 1, 1); PG8_STAGE(PG8_SB(1, 0), b3, voffB); PG8_STAGE(PG8_SB(1, 1), b3 + hstep, voffB); PG8_STAGE(PG8_SA(1, 0), a3, voffA);
            PG8_WAIT_V(8); PG8_WAIT_L(0); PG8_BAR; PG8_MMA(1, 0, At, B0); PG8_MMA(1, 1, At, B1); PG8_BAR; PG8_SCHED;
        }
        if constexpr (ALIGN_EPI) { if (wr == 0) PG8_BAR; }
        if constexpr (FP8) {
#pragma unroll
            for (int a = 0; a < 2; ++a)
#pragma unroll
                for (int b = 0; b < 2; ++b)
#pragma unroll
                    for (int m = 0; m < 4; ++m) { const f32x8 c_ = acc8[a][b][m]; acc[a][b][m][0] = __builtin_shufflevector(c_, c_, 0, 1, 2, 3); acc[a][b][m][1] = __builtin_shufflevector(c_, c_, 4, 5, 6, 7); }
        }
        const bool keep = Epi::keep(cur);
        E(acc, cur, wr, wc, fr, fq);
        if (!has_next) break;
#pragma unroll
        for (int a = 0; a < 2; ++a)
#pragma unroll
            for (int b = 0; b < 2; ++b)
#pragma unroll
                for (int m = 0; m < 4; ++m) {
                    if (!keep) { acc[a][b][m][0] = (f32x4){0.f, 0.f, 0.f, 0.f}; acc[a][b][m][1] = (f32x4){0.f, 0.f, 0.f, 0.f}; }
                    if constexpr (FP8) acc8[a][b][m] = __builtin_shufflevector(acc[a][b][m][0], acc[a][b][m][1], 0, 1, 2, 3, 4, 5, 6, 7); }
        cur = nxt; cA = nA; cB = nB; ++ui;
        if constexpr (ALIGN_EPI) { if (wr == 1) PG8_BAR; }
    }
    PG8_WAIT_V(0);
    if constexpr (!ALIGN_EPI) { if (wr == 0) PG8_BAR; }
    PG8_BAR;
#undef PG8_SA
#undef PG8_SB
#undef PG8_STAGE
#undef PG8_LDA
#undef PG8_LDB
#undef PG8_MMA
#undef PG8_WAIT_V
#undef PG8_WAIT_L
#undef PG8_BAR
#undef PG8_SCHED
#undef PG8_UA
#undef PG8_UB
}
}

namespace att {
constexpr int D = 128, LDR = 1024;
constexpr float SCALE = 0.08838834764831845f, INV_SCALE = 11.313708498984761f, THR = 8.f;
constexpr int NW = 8, QBLK = 32, KVBLK = 64, QB = NW * QBLK;
constexpr int SHM_V = KVBLK * D * 2, SHM_K = KVBLK * D * 2;
constexpr int OFF_WS = 2 * SHM_V + 2 * SHM_K, OFF_FL = OFF_WS + NW * 64 * 4  , OFF_TB = OFF_FL + FNEG_LD * 4  , OFF_QW = OFF_TB + 1040, LDS_USED = OFF_QW + 16;
enum { FOXP = 0, BANDP = 1, FOXS = 2, BANDS = 3 };
#define KSWZ(row, colB) ((row) * 256 + ((colB) ^ (((row) & 7) << 4)))
#define SBAR() __builtin_amdgcn_sched_barrier(0)
__device__ __forceinline__ int v_st(int k, int c) { const int kk = (k & ~0xC) | ((k & 4) << 1) | ((k & 8) >> 1); return ((kk >> 3) * 4 + (c >> 5)) * 512 + ((kk & 7) * 32 + (c & 31)) * 2; }
__device__ __forceinline__ int v_rd_base(int lane) { return ((lane & 3) << 3) | (((lane >> 2) & 3) << 6) | (((lane >> 4) & 1) << 5) | (((lane >> 5) & 1) << 8); }
constexpr int v_rd_off(int d0, int ks, int half) { return d0 * 512 + ks * 4096 + half * 2048; }
__device__ __forceinline__ int crow(int r, int hi) { return (r & 3) + 8 * (r >> 2) + 4 * hi; }
__device__ __forceinline__ unsigned cvtpk(float lo, float hi) { unsigned r; asm volatile("v_cvt_pk_bf16_f32 %0, %1, %2" : "=v"(r) : "v"(lo), "v"(hi)); return r; }
__device__ __forceinline__ unsigned o_quad_fp8(float v) {
    const float s = v * O_SCALE;
    const float sn = __shfl_xor(s, 1);
    const int pk = __builtin_amdgcn_cvt_pk_fp8_f32(s, sn, 0, false);
    const int pk2 = __builtin_amdgcn_update_dpp(pk, pk, 0x4E, 0xF, 0xF, false);
    return ((unsigned)pk & 0xFFFFu) | ((unsigned)pk2 << 16);
}
__device__ __forceinline__ bf16x8 pack8(f32x4 a, f32x4 b) { u32x4 w = {cvtpk(a[0], a[1]), cvtpk(a[2], a[3]), cvtpk(b[0], b[1]), cvtpk(b[2], b[3])}; return *reinterpret_cast<bf16x8*>(&w); }
__device__ __forceinline__ void mask_tile(f32x16& p0, f32x16& p1, int dq, unsigned W) {
    const float NEG = -__builtin_inff();
#pragma unroll
    for (int r = 0; r < 16; ++r) { const int c = (r & 3) + 8 * (r >> 2);
        if ((unsigned)(dq - c) >= W) p0[r] = NEG;
        if ((unsigned)(dq - c - 32) >= W) p1[r] = NEG; }
}
__device__ __forceinline__ void band_bias(f32x16& p0, f32x16& p1, int dq, const LAS float* tb) {
#pragma unroll
    for (int r = 0; r < 16; ++r) { const int c = (r & 3) + 8 * (r >> 2);
        int i0 = dq - c + 128; i0 = i0 < 0 ? 0 : (i0 > 256 ? 256 : i0);
        int i1 = dq - c - 32 + 128; i1 = i1 < 0 ? 0 : (i1 > 256 ? 256 : i1);
        p0[r] += tb[i0]; p1[r] += tb[i1]; }
}
__device__ __forceinline__ void partialSM(f32x16& p0, f32x16& p1, float& m_reg, float& mn, float& alpha) {
    float pmax = p0[0];
#pragma unroll
    for (int r = 1; r < 16; ++r) pmax = fmaxf(pmax, p0[r]);
#pragma unroll
    for (int r = 0; r < 16; ++r) pmax = fmaxf(pmax, p1[r]);
    { auto rr = __builtin_amdgcn_permlane32_swap(__float_as_uint(pmax), __float_as_uint(pmax), false, false);
      pmax = fmaxf(__uint_as_float(rr[0]), __uint_as_float(rr[1])); }
    constexpr float C2 = 1.4426950408889634f * SCALE;
    if (__builtin_expect(__all((pmax - m_reg) * SCALE <= THR), 1)) { mn = m_reg; alpha = 1.f; }
    else { mn = fmaxf(m_reg, pmax); alpha = __builtin_amdgcn_exp2f((m_reg - mn) * C2); m_reg = mn; }
    const float mnL = -mn * C2;
#pragma unroll
    for (int r = 0; r < 16; ++r) p0[r] = fmaf(p0[r], C2, mnL);
#pragma unroll
    for (int r = 0; r < 16; ++r) p1[r] = fmaf(p1[r], C2, mnL);
#pragma unroll
    for (int r = 0; r < 16; ++r) p0[r] = __builtin_amdgcn_exp2f(p0[r]);
}
__device__ __forceinline__ void finishSM(f32x16& p0, f32x16& p1, float alpha, float& l_reg, bf16x8& pa0, bf16x8& pa1, bf16x8& pa2, bf16x8& pa3) {
#pragma unroll
    for (int r = 0; r < 16; ++r) p1[r] = __builtin_amdgcn_exp2f(p1[r]);
    float ps = 0;
#pragma unroll
    for (int r = 0; r < 16; ++r) ps += p0[r];
#pragma unroll
    for (int r = 0; r < 16; ++r) ps += p1[r];
    { auto rr = __builtin_amdgcn_permlane32_swap(__float_as_uint(ps), __float_as_uint(ps), false, false);
      ps = __uint_as_float(rr[0]) + __uint_as_float(rr[1]); }
    l_reg = l_reg * alpha + ps;
#define PK4(P, B_, OUT) do { unsigned a0 = cvtpk(P[B_+0], P[B_+1]), a1 = cvtpk(P[B_+2], P[B_+3]);                          \
        unsigned b0 = cvtpk(P[B_+4], P[B_+5]), b1 = cvtpk(P[B_+6], P[B_+7]);                                             \
        auto r0 = __builtin_amdgcn_permlane32_swap(a0, b0, false, false); auto r1 = __builtin_amdgcn_permlane32_swap(a1, b1, false, false); \
        u32x4 w = {r0[0], r1[0], r0[1], r1[1]}; OUT = *reinterpret_cast<bf16x8*>(&w); } while (0)
    PK4(p0, 0, pa0); PK4(p0, 8, pa1); PK4(p1, 0, pa2); PK4(p1, 8, pa3);
#undef PK4
}
template <int KB, bool SK, bool FOX>
__device__ __forceinline__ void qkt(f32x16& p0, f32x16& p1, const char* K_lds, int r32, int hi, const bf16x8* qr, bool act, const LAS float* fb) {
    if (SK && !act) { const float NEG = -__builtin_inff();
#pragma unroll
        for (int r = 0; r < 16; ++r) { p0[r] = NEG; p1[r] = NEG; } return; }
    if constexpr (FOX) {
#pragma unroll
        for (int g = 0; g < 4; ++g) { const f32x4 a = *(const LAS f32x4*)(fb + 8 * g), b = *(const LAS f32x4*)(fb + 32 + 8 * g);
            p0[4 * g] = a[0]; p0[4 * g + 1] = a[1]; p0[4 * g + 2] = a[2]; p0[4 * g + 3] = a[3];
            p1[4 * g] = b[0]; p1[4 * g + 1] = b[1]; p1[4 * g + 2] = b[2]; p1[4 * g + 3] = b[3]; }
    } else { p0 = f32x16{}; p1 = f32x16{}; }
    const char* kb[4];
#pragma unroll
    for (int dd = 0; dd < 4; ++dd) kb[dd] = K_lds + KB * SHM_K + KSWZ(r32, (dd * 16 + hi * 8) * 2);
#pragma unroll
    for (int d0 = 0; d0 < 8; ++d0) { const char* a = kb[d0 & 3] + (d0 >> 2) * 128;
        bf16x8 b0 = *reinterpret_cast<const bf16x8*>(a);
        bf16x8 b1 = *reinterpret_cast<const bf16x8*>(a + 32 * 256);
        p0 = __builtin_amdgcn_mfma_f32_32x32x16_bf16(b0, qr[d0], p0, 0, 0, 0);
        p1 = __builtin_amdgcn_mfma_f32_32x32x16_bf16(b1, qr[d0], p1, 0, 0, 0); }
}
template <int VB, bool SK>
__device__ __forceinline__ void pv_tile(f32x16* o, int vb0, bf16x8 pa0, bf16x8 pa1, bf16x8 pa2, bf16x8 pa3, bool act) {
    if (SK && !act) return;
#define TRRD(dst, off) asm volatile("ds_read_b64_tr_b16 %0, %1 offset:%2" : "=&v"(dst) : "v"(vb0), "i"(off) : "memory")
#define PV_D0(d0) do { s16x4 l0, l1, l2, l3, h0, h1, h2, h3; constexpr int b_ = VB * SHM_V + v_rd_off(d0, 0, 0); \
        TRRD(l0, b_); TRRD(h0, b_ + 2048); TRRD(l1, b_ + 4096); TRRD(h1, b_ + 6144); TRRD(l2, b_ + 8192); TRRD(h2, b_ + 10240); TRRD(l3, b_ + 12288); TRRD(h3, b_ + 14336); \
        asm volatile("s_waitcnt lgkmcnt(0)" ::: "memory"); SBAR();   \
        o[d0] = __builtin_amdgcn_mfma_f32_32x32x16_bf16(pa0, (bf16x8){l0[0], l0[1], l0[2], l0[3], h0[0], h0[1], h0[2], h0[3]}, o[d0], 0, 0, 0);   \
        o[d0] = __builtin_amdgcn_mfma_f32_32x32x16_bf16(pa1, (bf16x8){l1[0], l1[1], l1[2], l1[3], h1[0], h1[1], h1[2], h1[3]}, o[d0], 0, 0, 0);   \
        o[d0] = __builtin_amdgcn_mfma_f32_32x32x16_bf16(pa2, (bf16x8){l2[0], l2[1], l2[2], l2[3], h2[0], h2[1], h2[2], h2[3]}, o[d0], 0, 0, 0);   \
        o[d0] = __builtin_amdgcn_mfma_f32_32x32x16_bf16(pa3, (bf16x8){l3[0], l3[1], l3[2], l3[3], h3[0], h3[1], h3[2], h3[3]}, o[d0], 0, 0, 0); } while (0)
    PV_D0(0); PV_D0(1); PV_D0(2); PV_D0(3);
#undef PV_D0
#undef TRRD
}

struct Job { const bf16* Q; bf16* O; const void* K; const void* V; const float* Kn; const float* Vn; int P0, j_lo, j_hi; };
struct Seam { bf16x8 qr[8]; bf16x8 st_v0, st_v1, st_k0, st_k1; f32x4 sf0, sf1, sf2, sf3; };
template <int MODE> struct Cfg {
    static constexpr bool F32 = MODE >= FOXS, SHQ = MODE >= FOXS, FOX = (MODE == FOXP || MODE == FOXS), BAND = !FOX, SK = (MODE == BANDP);
    static constexpr int NC = MODE == FOXS ? PAST : (MODE == BANDS ? LBAND : (1 << 30));
    static constexpr int NVALID = LBAND + TS;
};
#define VMW() asm volatile("s_waitcnt vmcnt(0)" ::: "memory")
#define VMWN(n) asm volatile("s_waitcnt vmcnt(%0)" :: "i"(n) : "memory")
#define SLOAD_H(Kp, Vp, k0) do { const char* kt_ = (const char*)(Kp) + (size_t)(k0) * (LDR * 2); const char* vt_ = (const char*)(Vp) + (size_t)(k0) * (LDR * 2); \
                                 S.st_v0 = *(const bf16x8*)(vt_ + kvo2); S.st_v1 = *(const bf16x8*)(vt_ + 32 * LDR * 2 + kvo2);              \
                                 S.st_k0 = *(const bf16x8*)(kt_ + kvo2); S.st_k1 = *(const bf16x8*)(kt_ + 32 * LDR * 2 + kvo2); } while (0)
#define SWRITE_HK(bf) do { *(bf16x8*)(K_lds + (bf) * SHM_K + kws) = S.st_k0; *(bf16x8*)(K_lds + (bf) * SHM_K + kws + 32 * 256) = S.st_k1; } while (0)
#define SWRITE_HV(bf) do { *(bf16x8*)(V_lds + (bf) * SHM_V + vst0) = S.st_v0; *(bf16x8*)(V_lds + (bf) * SHM_V + vst1) = S.st_v1; } while (0)
#define SWRITE_H(bf) do { SWRITE_HV(bf); SWRITE_HK(bf); } while (0)
#define SLOAD_F(pc, pnw, k0) do { const bool nw_ = (k0) >= C::NC; const char* b_ = nw_ ? (const char*)(pnw) : (const char*)(pc) + (size_t)(k0) * (LDR * 4); \
        const char* b1_ = b_ + (nw_ ? 0 : 32 * LDR * 4);                                                                                    \
        S.sf0 = *(const f32x4*)(b_ + kvo4); S.sf1 = *(const f32x4*)(b_ + 16 + kvo4); S.sf2 = *(const f32x4*)(b1_ + kvo4); S.sf3 = *(const f32x4*)(b1_ + 16 + kvo4); } while (0)
#define SWRITE_KF(bf) do { *(bf16x8*)(K_lds + (bf) * SHM_K + kws) = pack8(S.sf0, S.sf1); *(bf16x8*)(K_lds + (bf) * SHM_K + kws + 32 * 256) = pack8(S.sf2, S.sf3); } while (0)
#define SWRITE_VF(bf) do { *(bf16x8*)(V_lds + (bf) * SHM_V + vst0) = pack8(S.sf0, S.sf1); *(bf16x8*)(V_lds + (bf) * SHM_V + vst1) = pack8(S.sf2, S.sf3); } while (0)

template <int MODE>
__device__ __forceinline__ void attn_prime(const Job& cur, char* lds, Seam& S, const int wid) {
    using C = Cfg<MODE>;
    const int lane = lane_id(), tid = wid * 64 + lane, r32 = lane & 31, hi = lane >> 5;
    const int sr = tid >> 4, sc = (tid & 15) * 8, kws = KSWZ(sr, sc * 2); char* K_lds = lds + 2 * SHM_V;
    const unsigned kvo2 = (unsigned)(sr * LDR + sc) * 2u, kvo4 = (unsigned)(sr * LDR + sc) * 4u; (void)kvo2; (void)kvo4;
    const int kb0 = cur.j_lo * KVBLK;
    { const char* Qu = (const char*)cur.Q + (size_t)(C::SHQ ? 0 : wid * QBLK) * (LDR * 2); const unsigned qo = (unsigned)(r32 * LDR + hi * 8) * 2u;
#pragma unroll
      for (int d0 = 0; d0 < 8; ++d0) S.qr[d0] = *(const bf16x8*)(Qu + d0 * 32 + qo); }
    if constexpr (C::F32) { SLOAD_F(cur.K, cur.Kn, kb0); VMW(); SWRITE_KF(0); SBAR(); SLOAD_F(cur.V, cur.Vn, kb0); }
    else { SLOAD_H(cur.K, cur.V, kb0); VMW(); SWRITE_HK(0); }
    __syncthreads();
}
template <int MODE>
__device__ __forceinline__ void attn_block(const Job& cur, const Job& nxt, char* lds, Seam& S, const int wid) {
    using C = Cfg<MODE>;
    constexpr bool F32 = C::F32, SK = C::SK;
    const int lane = lane_id(), tid = wid * 64 + lane, r32 = lane & 31, hi = lane >> 5;
    const int j_lo = cur.j_lo, NT = cur.j_hi - cur.j_lo;
    const int kbn = nxt.j_lo * KVBLK;
    const int qlo = cur.P0 + (C::SHQ ? 0 : wid * QBLK), qm = qlo + r32 - 4 * hi;
    const int cw = (cur.P0 >> 6) + (wid >> 1);
    char* V_lds = lds; char* K_lds = lds + 2 * SHM_V;
    float* ws = (float*)(lds + OFF_WS) + wid * 64; float* li_l = ws, * al_l = ws + 32;
    const LAS float* FLh = (const LAS float*)(LAS char*)(lds + OFF_FL) + 4 * hi;
    const LAS float* TB = (const LAS float*)(LAS char*)(lds + OFF_TB);
    float m_reg = -1e30f, l_reg = 0; f32x16 o[4] = {};
    const int sr = tid >> 4, sc = (tid & 15) * 8, vst0 = v_st(sr, sc), vst1 = v_st(32 + sr, sc), kws = KSWZ(sr, sc * 2);
    const unsigned kvo2 = (unsigned)(sr * LDR + sc) * 2u, kvo4 = (unsigned)(sr * LDR + sc) * 4u; (void)kvo2; (void)kvo4;
    const int vb0 = (int)(uintptr_t)V_lds + v_rd_base(lane);
#define RESC(a) do { if (__any((a) < 1.f)) { if (hi == 0) al_l[r32] = (a); asm volatile("s_waitcnt lgkmcnt(0)" ::: "memory");              \
                     _Pragma("unroll") for (int d_ = 0; d_ < 4; ++d_) _Pragma("unroll") for (int r = 0; r < 16; ++r) o[d_][r] *= al_l[crow(r, hi)]; } } while (0)
#define KBASE(t) ((j_lo + (t)) * KVBLK)
#define ACT(t) (!SK || ((j_lo + (t)) >= cw - 8 && (j_lo + (t)) <= cw))
#define MASKT(P0_, P1_, t) do { const int kb_ = KBASE(t);                                                                                   \
        if constexpr (C::BAND) { if (ACT(t) && kb_ + KVBLK - 1 > qlo - 128) band_bias(P0_, P1_, qm - kb_, TB); }                            \
        if constexpr (C::FOX) { if (kb_ + KVBLK - 1 > qlo) mask_tile(P0_, P1_, qm - kb_, 0x40000000u); }                                    \
        if constexpr (MODE == BANDS) { if (kb_ + KVBLK - 1 >= C::NVALID) mask_tile(P0_, P1_, (C::NVALID - 1 - 4 * hi) - kb_, 0x40000000u); } } while (0)
#define FB(t) (FLh + KBASE(t))
    constexpr int NQL = 8;
#define SEAM_K0() do { VMWN(NQL); if constexpr (F32) { SWRITE_KF(0); SBAR(); SLOAD_F(nxt.V, nxt.Vn, kbn); } else { SWRITE_HK(0); } SBAR(); } while (0)
    f32x16 pA0, pA1, pB0, pB1; float mnA, mnB, alA, alB; bf16x8 pa0, pa1, pa2, pa3;
    if constexpr (F32) { VMW(); SWRITE_VF(0); SBAR(); } else { SWRITE_HV(0); SBAR(); }
    if (NT > 1) { if constexpr (F32) SLOAD_F(cur.K, cur.Kn, KBASE(1)); else SLOAD_H(cur.K, cur.V, KBASE(1)); }
    SBAR(); qkt<0, SK, C::FOX>(pA0, pA1, K_lds, r32, hi, S.qr, ACT(0), FB(0));
    if constexpr (F32) { if (NT > 1) { VMW(); SWRITE_KF(1); SBAR(); SLOAD_F(cur.V, cur.Vn, KBASE(1)); } }
    MASKT(pA0, pA1, 0); partialSM(pA0, pA1, m_reg, mnA, alA);
    if (NT > 1) { VMW(); if constexpr (F32) { SWRITE_VF(1); SBAR(); if (NT > 2) SLOAD_F(cur.K, cur.Kn, KBASE(2)); } else SWRITE_H(1); }
    __syncthreads();
#define HALF_STEP(PX0, PX1, mnX, alX, PY0, PY1, alY, t, KB, VB, SB) do {                                                      \
        SBAR(); qkt<KB, SK, C::FOX>(PX0, PX1, K_lds, r32, hi, S.qr, ACT(t), FB(t));                                           \
        finishSM(PY0, PY1, alY, l_reg, pa0, pa1, pa2, pa3); SBAR();                                                           \
        if ((t) + 1 < NT) { if constexpr (F32) { VMW(); SWRITE_KF(SB); SBAR(); SLOAD_F(cur.V, cur.Vn, KBASE((t) + 1)); }      \
                            else { SLOAD_H(cur.K, cur.V, KBASE((t) + 1)); } SBAR(); }                                         \
        pv_tile<VB, SK>(o, vb0, pa0, pa1, pa2, pa3, ACT((t) - 1)); MASKT(PX0, PX1, (t)); partialSM(PX0, PX1, m_reg, mnX, alX); \
        __syncthreads();                                                                                                      \
        if ((t) + 1 < NT) { VMW(); if constexpr (F32) { SWRITE_VF(SB); SBAR(); if ((t) + 2 < NT) SLOAD_F(cur.K, cur.Kn, KBASE((t) + 2)); } \
                            else { SWRITE_H(SB); } }                                                                          \
        RESC(alX); __syncthreads(); } while (0)
    for (int t = 1; t + 1 < NT; t += 2) {
        HALF_STEP(pB0, pB1, mnB, alB, pA0, pA1, alA, t, 1, 0, 0);
        HALF_STEP(pA0, pA1, mnA, alA, pB0, pB1, alB, t + 1, 0, 1, 1);
    }
    const bool even = (NT & 1) == 0;
    if (even) { SBAR(); qkt<1, SK, C::FOX>(pB0, pB1, K_lds, r32, hi, S.qr, ACT(NT - 1), FB(NT - 1)); SBAR(); }
    if constexpr (F32) { SLOAD_F(nxt.K, nxt.Kn, kbn); SBAR(); }
    else { SLOAD_H(nxt.K, nxt.V, kbn); SBAR(); }
    { const char* Qu = (const char*)nxt.Q + (size_t)(C::SHQ ? 0 : wid * QBLK) * (LDR * 2); const unsigned qo = (unsigned)(r32 * LDR + hi * 8) * 2u;
#pragma unroll
      for (int d0 = 0; d0 < 8; ++d0) S.qr[d0] = *(const bf16x8*)(Qu + d0 * 32 + qo); }
    SBAR();
    finishSM(pA0, pA1, alA, l_reg, pa0, pa1, pa2, pa3); SBAR();
    pv_tile<0, SK>(o, vb0, pa0, pa1, pa2, pa3, ACT(even ? NT - 2 : NT - 1));
    if (even) { MASKT(pB0, pB1, NT - 1); partialSM(pB0, pB1, m_reg, mnB, alB); __syncthreads(); RESC(alB);
        finishSM(pB0, pB1, alB, l_reg, pa0, pa1, pa2, pa3); SBAR(); pv_tile<1, SK>(o, vb0, pa0, pa1, pa2, pa3, ACT(NT - 1)); }
    SBAR(); SEAM_K0();
    if (hi == 0) li_l[r32] = l_reg; asm volatile("s_waitcnt lgkmcnt(0)" ::: "memory");
    float rli[16];
#pragma unroll
    for (int r = 0; r < 16; ++r) rli[r] = __builtin_amdgcn_rcpf(li_l[crow(r, hi)]);
    char* Ou = (char*)cur.O + (size_t)(C::SHQ ? 0 : wid * QBLK) * LDR; const unsigned oo = (unsigned)(4 * hi * LDR + r32);
    if (!C::SHQ || wid == 0) {
#pragma unroll
        for (int r = 0; r < 16; ++r) { const int orc = (r & 3) + 8 * (r >> 2);
#pragma unroll
            for (int d0 = 0; d0 < 4; ++d0) { const unsigned w8 = o_quad_fp8(o[d0][r] * rli[r]);
                if ((r32 & 3) == 0) *(unsigned*)(Ou + (size_t)(orc * LDR + d0 * 32) + oo) = w8; } }
    }
    __syncthreads();
#undef RESC
#undef KBASE
#undef ACT
#undef MASKT
#undef FB
#undef SEAM_K0
#undef HALF_STEP
}
__device__ __forceinline__ void foxs_unit(const bf16* Q, bf16* O, const float* Kc, const float* Vc, const float* Kn, const float* Vn, const float* fn, char* lds, const int wid) {
    const int lane = lane_id(), r32 = lane & 31, hi = lane >> 5;
    char* Kw = lds + wid * 16384; char* Vw = Kw + 8192;
    float* wsf = (float*)(lds + 131072 + 1024) + wid * 64;
    float* ml = (float*)(lds + 131072 + 4096);
    constexpr float C2 = 1.4426950408889634f * SCALE;
    bf16x8 qr[8];
    { const char* Qu = (const char*)Q; const unsigned qo = (unsigned)(r32 * LDR + hi * 8) * 2u;
#pragma unroll
      for (int d0 = 0; d0 < 8; ++d0) qr[d0] = *(const bf16x8*)(Qu + d0 * 32 + qo); }
    float m_reg = -1e30f, l_reg = 0.f; f32x16 o[4] = {};
    const int srow = lane >> 4, scol = (lane & 15) * 8;
    const unsigned so4 = (unsigned)(srow * LDR + scol) * 4u;
    const int vb0 = (int)(uintptr_t)Vw + v_rd_base(lane);
    for (int c = wid; c < 129; c += 8) {
        const int kb = c * 32; const bool nw = (c == 128);
        const char* kbase = nw ? (const char*)Kn : (const char*)Kc + (size_t)kb * (LDR * 4);
        const char* vbase = nw ? (const char*)Vn : (const char*)Vc + (size_t)kb * (LDR * 4);
        f32x4 st[16];
#pragma unroll
        for (int i = 0; i < 8; ++i) { const char* rp = kbase + (size_t)(4 * i) * (LDR * 4) + so4; st[2 * i] = *(const f32x4*)rp; st[2 * i + 1] = *(const f32x4*)(rp + 16); }
        f32x16 p0;
        { const float* fb = fn + kb + 4 * hi;
#pragma unroll
          for (int g = 0; g < 4; ++g) { const f32x4 a = *(const f32x4*)(fb + 8 * g); p0[4 * g] = a[0]; p0[4 * g + 1] = a[1]; p0[4 * g + 2] = a[2]; p0[4 * g + 3] = a[3]; } }
#pragma unroll
        for (int i = 0; i < 8; ++i) { const int row = 4 * i + srow; *(bf16x8*)(Kw + KSWZ(row, scol * 2)) = pack8(st[2 * i], st[2 * i + 1]); }
        SBAR();
#pragma unroll
        for (int i = 0; i < 8; ++i) { const char* rp = vbase + (size_t)(4 * i) * (LDR * 4) + so4; st[2 * i] = *(const f32x4*)rp; st[2 * i + 1] = *(const f32x4*)(rp + 16); }
        asm volatile("s_waitcnt lgkmcnt(0)" ::: "memory"); SBAR();
#pragma unroll
        for (int d0 = 0; d0 < 8; ++d0) { const bf16x8 b0 = *reinterpret_cast<const bf16x8*>(Kw + KSWZ(r32, (d0 * 16 + hi * 8) * 2));
            p0 = __builtin_amdgcn_mfma_f32_32x32x16_bf16(b0, qr[d0], p0, 0, 0, 0); }
        if (nw) { const float NEG = -__builtin_inff();
#pragma unroll
            for (int r = 0; r < 16; ++r) if (crow(r, hi) > r32) p0[r] = NEG; }
        float pmax = p0[0];
#pragma unroll
        for (int r = 1; r < 16; ++r) pmax = fmaxf(pmax, p0[r]);
        { auto rr = __builtin_amdgcn_permlane32_swap(__float_as_uint(pmax), __float_as_uint(pmax), false, false);
          pmax = fmaxf(__uint_as_float(rr[0]), __uint_as_float(rr[1])); }
        float mn, alpha;
        if (__all((pmax - m_reg) * SCALE <= THR)) { mn = m_reg; alpha = 1.f; }
        else { mn = fmaxf(m_reg, pmax); alpha = __builtin_amdgcn_exp2f((m_reg - mn) * C2); m_reg = mn; }
        const float mnL = -mn * C2; float ps = 0.f;
#pragma unroll
        for (int r = 0; r < 16; ++r) { p0[r] = __builtin_amdgcn_exp2f(fmaf(p0[r], C2, mnL)); ps += p0[r]; }
        { auto rr = __builtin_amdgcn_permlane32_swap(__float_as_uint(ps), __float_as_uint(ps), false, false);
          ps = __uint_as_float(rr[0]) + __uint_as_float(rr[1]); }
        l_reg = l_reg * alpha + ps;
        bf16x8 pa0, pa1;
#define PK4(P, B_, OUT) do { unsigned a0 = cvtpk(P[B_+0], P[B_+1]), a1 = cvtpk(P[B_+2], P[B_+3]);                          \
        unsigned b0_ = cvtpk(P[B_+4], P[B_+5]), b1_ = cvtpk(P[B_+6], P[B_+7]);                                           \
        auto r0 = __builtin_amdgcn_permlane32_swap(a0, b0_, false, false); auto r1 = __builtin_amdgcn_permlane32_swap(a1, b1_, false, false); \
        u32x4 w = {r0[0], r1[0], r0[1], r1[1]}; OUT = *reinterpret_cast<bf16x8*>(&w); } while (0)
        PK4(p0, 0, pa0); PK4(p0, 8, pa1);
#undef PK4
#pragma unroll
        for (int i = 0; i < 8; ++i) { const int row = 4 * i + srow; *(bf16x8*)(Vw + v_st(row, scol)) = pack8(st[2 * i], st[2 * i + 1]); }
        if (__any(alpha < 1.f)) { if (hi == 0) wsf[r32] = alpha; asm volatile("s_waitcnt lgkmcnt(0)" ::: "memory");
#pragma unroll
            for (int d_ = 0; d_ < 4; ++d_)
#pragma unroll
                for (int r = 0; r < 16; ++r) o[d_][r] *= wsf[crow(r, hi)]; }
        asm volatile("s_waitcnt lgkmcnt(0)" ::: "memory"); SBAR();
#define TRRD(dst, off) asm volatile("ds_read_b64_tr_b16 %0, %1 offset:%2" : "=&v"(dst) : "v"(vb0), "i"(off) : "memory")
#define PV_D0(d0) do { s16x4 l0, l1, h0, h1; constexpr int b_ = v_rd_off(d0, 0, 0);                                        \
        TRRD(l0, b_); TRRD(h0, b_ + 2048); TRRD(l1, b_ + 4096); TRRD(h1, b_ + 6144);                                       \
        asm volatile("s_waitcnt lgkmcnt(0)" ::: "memory"); SBAR();                                                         \
        o[d0] = __builtin_amdgcn_mfma_f32_32x32x16_bf16(pa0, (bf16x8){l0[0], l0[1], l0[2], l0[3], h0[0], h0[1], h0[2], h0[3]}, o[d0], 0, 0, 0);   \
        o[d0] = __builtin_amdgcn_mfma_f32_32x32x16_bf16(pa1, (bf16x8){l1[0], l1[1], l1[2], l1[3], h1[0], h1[1], h1[2], h1[3]}, o[d0], 0, 0, 0); } while (0)
        PV_D0(0); PV_D0(1); PV_D0(2); PV_D0(3);
#undef PV_D0
#undef TRRD
        asm volatile("s_waitcnt lgkmcnt(0)" ::: "memory"); SBAR();
    }
    __syncthreads();
    { float* ow = (float*)(lds + wid * 16384);
#pragma unroll
      for (int d0 = 0; d0 < 4; ++d0)
#pragma unroll
          for (int r = 0; r < 16; ++r) ow[(d0 * 16 + r) * 64 + lane] = o[d0][r];
      if (hi == 0) { ml[wid * 64 + r32] = m_reg; ml[wid * 64 + 32 + r32] = l_reg; } }
    __syncthreads();
    { const int d0 = wid >> 1, rbase = (wid & 1) * 8;
#pragma unroll
      for (int rr = 0; rr < 8; ++rr) { const int r = rbase + rr, q = crow(r, hi);
          float mstar = ml[q];
#pragma unroll
          for (int sw = 1; sw < 8; ++sw) mstar = fmaxf(mstar, ml[sw * 64 + q]);
          float num = 0.f, den = 0.f;
#pragma unroll
          for (int sw = 0; sw < 8; ++sw) { const float f = __builtin_amdgcn_exp2f((ml[sw * 64 + q] - mstar) * C2);
              den += f * ml[sw * 64 + 32 + q]; num += f * ((const float*)(lds + sw * 16384))[(d0 * 16 + r) * 64 + lane]; }
          const unsigned w8 = o_quad_fp8(num * __builtin_amdgcn_rcpf(den));
          if ((r32 & 3) == 0) *(unsigned*)((char*)O + (size_t)q * LDR + d0 * 32 + r32) = w8; } }
    __syncthreads();
}
#undef VMW
#undef VMWN
#undef SLOAD_H
#undef SWRITE_HK
#undef SWRITE_HV
#undef SWRITE_H
#undef SLOAD_F
#undef SWRITE_KF
#undef SWRITE_VF
#undef SBAR
}

#define XB_TMO      128
#define XB_XCNT(j)  (256  + 64 * (j))
#define XB_XSUB(j)  (1280 + 64 * (j))
#define XB_XGEN(j)  (2304 + 64 * (j))
#define XB_TOP      3328
#define XB_TOPGEN   3392
#define XCD_BAR_WORDS 3456
#define XB_SPIN_CAP (1u << 18)
__device__ __forceinline__ unsigned xb_ld(unsigned* p)              { return __hip_atomic_load(p, __ATOMIC_RELAXED, __HIP_MEMORY_SCOPE_AGENT); }
__device__ __forceinline__ unsigned xb_add(unsigned* p, unsigned v) { return __hip_atomic_fetch_add(p, v, __ATOMIC_RELAXED, __HIP_MEMORY_SCOPE_AGENT); }
__device__ __forceinline__ unsigned xb_xcc_id() { return (unsigned)__builtin_amdgcn_s_getreg((3 << 11) | 20) & 0xFu; }
#define XB_SPIN(cond, bar) do { unsigned _sp = 0; while (cond) { __builtin_amdgcn_s_sleep(1); \
    if ((++_sp & 255u) == 0u) { if (xb_ld(&(bar)[XB_TMO])) break; if (_sp > XB_SPIN_CAP) { atomicAdd(&(bar)[XB_TMO], 1u); break; } } } } while (0)
struct XcdBarrier { unsigned* bar; unsigned x; volatile LAS unsigned* st; };
__device__ __forceinline__ XcdBarrier xcd_barrier_post(unsigned* bar, volatile LAS unsigned* st, const int wid) {
    XcdBarrier b; b.bar = bar; b.x = xb_xcc_id(); b.st = st;
    if (wid == 0 && lane_id() == 0) (void)xb_add(&bar[XB_XCNT(b.x)], 1u);
    return b;
}
__device__ __forceinline__ void xcd_barrier_complete(unsigned* bar, unsigned x, unsigned& nloc, unsigned& nx) {
    const unsigned G = gridDim.x * gridDim.y * gridDim.z;
    unsigned sum, cnt, mine, sp = 0u;
    for (;;) {
        sum = 0u; cnt = 0u; mine = 0u;
#pragma unroll
        for (unsigned j = 0; j < 16; ++j) { const unsigned c = xb_ld(&bar[XB_XCNT(j)]); sum += c; cnt += (c > 0u) ? 1u : 0u; mine = (j == x) ? c : mine; }
        if (sum == G) break;
        __builtin_amdgcn_s_sleep(1);
        if ((++sp & 255u) == 0u) { if (xb_ld(&bar[XB_TMO])) break; if (sp > XB_SPIN_CAP) { atomicAdd(&bar[XB_TMO], 1u); break; } }
    }
    nloc = mine > 0u ? mine : 1u; nx = cnt > 0u ? cnt : 1u;
}
__device__ __forceinline__ void xcd_barrier(const XcdBarrier& b, const int wid) {
    asm volatile("s_waitcnt vmcnt(0)" ::: "memory");
    __syncthreads();
    if (wid == 0 && lane_id() == 0) {
        unsigned* bar = b.bar;
        __builtin_amdgcn_s_waitcnt(0);
        unsigned nloc = b.st[0], nx = b.st[1];
        if (nloc == 0u) { xcd_barrier_complete(bar, b.x, nloc, nx); b.st[0] = nloc; b.st[1] = nx; }
        const unsigned old = xb_add(&bar[XB_XSUB(b.x)], 1u);
        const unsigned gen = old / nloc;
        if (old + 1u == (gen + 1u) * nloc) {
            __builtin_amdgcn_fence(__ATOMIC_RELEASE, "agent");
            asm volatile("s_waitcnt vmcnt(0)" ::: "memory");
            const unsigned og = xb_add(&bar[XB_TOP], 1u);
            const unsigned tg = og / nx;
            if (og + 1u == (tg + 1u) * nx) xb_add(&bar[XB_TOPGEN], 1u);
            else XB_SPIN(xb_ld(&bar[XB_TOPGEN]) == tg, bar);
            __builtin_amdgcn_fence(__ATOMIC_ACQUIRE, "agent");
            xb_add(&bar[XB_XGEN(b.x)], 1u);
            asm volatile("s_waitcnt vmcnt(0)" ::: "memory");
        } else {
            XB_SPIN(xb_ld(&bar[XB_XGEN(b.x)]) == gen, bar);
            __builtin_amdgcn_fence(__ATOMIC_ACQUIRE, "agent");
            asm volatile("s_waitcnt vmcnt(0)" ::: "memory");
        }
    }
    __syncthreads();
}

__device__ __forceinline__ const float* arg_in(int i) {
    const __attribute__((address_space(4))) char* kp = (const __attribute__((address_space(4))) char*)__builtin_amdgcn_kernarg_segment_ptr();
    asm volatile("" : "+s"(kp));
    return *(const float* const __attribute__((address_space(4)))*)(kp + 8 * i);
}
struct TItem { const float* src; bf16* dst; int ld, K, f8; float sc; };
__device__ __forceinline__ TItem titem_decode(int it, unsigned char* ws) {
    TItem t; const float* W; bf16* Wt; int ld, K, kb, nb, srccol, destrow;
    if (it < 10240) { W = arg_in(12); ld = NIN_SRC; K = DM; Wt = (bf16*)(ws + WS_WIN); kb = it / 320; nb = it % 320; destrow = nb * 32; srccol = destrow + (destrow >= 3072 ? 8 : 0);
        const int tl = destrow >> 8;
        if (tl < 4 || (tl >= 12 && tl < 16) || tl >= 24) { t.src = W + (size_t)(kb * 64) * ld + srccol; t.dst = (bf16*)(ws + WS_WIN8 + (size_t)destrow * K + kb * 64); t.ld = ld; t.K = K; t.f8 = 1; t.sc = WIN_SCALE; return t; } }
    else if ((it -= 10240) < 2048) { const int ob = it >= 1024; it -= ob * 1024; W = arg_in(ob ? 16 : 15); ld = DM; K = DH; Wt = (bf16*)(ws + (ob ? WS_WOB : WS_WOA)); kb = it / 64; nb = it % 64; destrow = srccol = nb * 32;
        t.src = W + (size_t)(kb * 64) * ld + srccol; t.dst = (bf16*)((unsigned char*)Wt + (size_t)destrow * K + kb * 64); t.ld = ld; t.K = K; t.f8 = 1; t.sc = WO_SCALE; return t; }
    else if ((it -= 2048) < 2048) { W = arg_in(17); ld = DM; K = DM; Wt = (bf16*)(ws + WS_WOUT); kb = it / 64; nb = it % 64; destrow = srccol = nb * 32;
        t.src = W + (size_t)(kb * 64) * ld + srccol; t.dst = (bf16*)((unsigned char*)Wt + (size_t)destrow * K + kb * 64); t.ld = ld; t.K = K; t.f8 = 1; t.sc = WOUT_SCALE; return t; }
    else if ((it -= 2048) < 5632) { W = arg_in(19); ld = DFF; K = DM; Wt = (bf16*)(ws + WS_WGU); kb = it / 176; nb = it % 176; srccol = nb * 32; destrow = (srccol >> 7) * 256 + (srccol & 127); }
    else if ((it -= 5632) < 5632) { W = arg_in(20); ld = DFF; K = DM; Wt = (bf16*)(ws + WS_WGU); kb = it / 176; nb = it % 176; srccol = nb * 32; destrow = (srccol >> 7) * 256 + 128 + (srccol & 127); }
    else { it -= 5632; W = arg_in(21); ld = DM; K = DFF; Wt = (bf16*)(ws + WS_WDN); kb = it / 64; nb = it % 64; destrow = srccol = nb * 32;
        t.src = W + (size_t)(kb * 64) * ld + srccol; t.dst = (bf16*)((unsigned char*)Wt + (size_t)destrow * K + kb * 64); t.ld = ld; t.K = K; t.f8 = 1; t.sc = WDN_SCALE; return t; }
    t.src = W + (size_t)(kb * 64) * ld + srccol; t.dst = Wt + (size_t)destrow * K + kb * 64; t.ld = ld; t.K = K; t.f8 = 0; t.sc = 1.0f; return t;
}
__device__ __forceinline__ void titem_load(const TItem& t, f32x4 (&b)[8], int lane) {
    const float* p = t.src + (size_t)(lane >> 3) * t.ld + 4 * (lane & 7);
#pragma unroll
    for (int i = 0; i < 8; ++i) b[i] = *(const f32x4*)(p + (size_t)(i * 8) * t.ld);
}
__device__ __forceinline__ void titem_store(const TItem& t, const f32x4 (&b)[8], LAS float* scr, int lane) {
#pragma unroll
    for (int i = 0; i < 8; ++i) { LAS float* w = scr + (i * 8 + (lane >> 3)) * 33 + 4 * (lane & 7); w[0] = b[i].x; w[1] = b[i].y; w[2] = b[i].z; w[3] = b[i].w; }
    LDS_WAIT(); asm volatile("" ::: "memory");
    const int c = lane & 7;
#pragma unroll
    for (int j = 0; j < 4; ++j) { const int n = (lane >> 3) + 8 * j; const LAS float* s = scr + (8 * c) * 33 + n;
        if (t.f8) { u32x2 o8; o8.x = cvt_pk4_fp8(s[0 * 33] * t.sc, s[1 * 33] * t.sc, s[2 * 33] * t.sc, s[3 * 33] * t.sc);
            o8.y = cvt_pk4_fp8(s[4 * 33] * t.sc, s[5 * 33] * t.sc, s[6 * 33] * t.sc, s[7 * 33] * t.sc);
            *(GAS u32x2*)((unsigned char*)t.dst + (size_t)n * t.K + 8 * c) = o8; continue; }
        v4u o; o.x = cvt_pk_bf16(s[0 * 33], s[1 * 33]); o.y = cvt_pk_bf16(s[2 * 33], s[3 * 33]); o.z = cvt_pk_bf16(s[4 * 33], s[5 * 33]); o.w = cvt_pk_bf16(s[6 * 33], s[7 * 33]);
        *(GAS v4u*)(t.dst + (size_t)n * t.K + 8 * c) = o; }
    LDS_WAIT(); asm volatile("" ::: "memory");
}
__device__ __forceinline__ float log_sigmoid_f(float x) { return fminf(x, 0.f) - log1pf(expf(-fabsf(x))); }

struct Args { const float* in[23]; float* out; unsigned char* ws; int ph_lo, ph_hi; };
static_assert(sizeof(Args) == 25 * 8 + 8, "Args has no padding");

__global__ void __launch_bounds__(NTHREADS, 2) fwd_kernel(Args args) {
    extern __shared__ __attribute__((aligned(16))) unsigned char lds[];
    LAS unsigned char* L = (LAS unsigned char*)lds;
    volatile LAS unsigned* MISC = (volatile LAS unsigned*)(L + MISC_OFF);
    const int wave = __builtin_amdgcn_readfirstlane(threadIdx.x >> 6);
    const int G = gridDim.x, bx = blockIdx.x;
#define TIDS() const int lane = lane_id(), tid = wave * 64 + lane; (void)tid; (void)lane
    const int vcu = (G % 8 == 0) ? (bx % 8) * (G / 8) + bx / 8 : bx;
    unsigned char* ws = args.ws; float* out = args.out;
    gu32* ctl = (gu32*)(ws + WS_CTL);
    float* mod = (float*)(ws + WS_MOD);
    float* fneg = (float*)(ws + WS_FNEG);
    bf16* Hb = (bf16*)(ws + WS_H);
    bf16* QKV = (bf16*)(ws + WS_QKV);
    bf16* ZA = (bf16*)(ws + WS_ZA); bf16* ZB = (bf16*)(ws + WS_ZB);
    bf16* ACT = (bf16*)(ws + WS_ACT);
    bf16* X1B = (bf16*)(ws + WS_ZB);
    { TIDS(); for (int u = tid; u < (LDS_BYTES - LDSCTL_OFF) / 4; u += NTHREADS) ((LAS unsigned*)(L + LDSCTL_OFF))[u] = 0u; }
    __syncthreads();
    XcdBarrier bar; bar.bar = (unsigned*)(ctl + CW_BAR); bar.x = 0; bar.st = nullptr;
    if (MK_N_LAUNCHES == 1) bar = xcd_barrier_post((unsigned*)(ctl + CW_BAR), MISC + 8, wave);
    const int lo = args.ph_lo, hi = args.ph_hi;
#define IN(k) (lo <= (k) && (k) < hi)
#define SEAM(k) do { if (IN(k) && IN((k) + 1)) xcd_barrier(bar, wave); } while (0)
    const int gw = vcu * NWAVES + wave, NGW = G * NWAVES;

    if (IN(0)) {
        TIDS();
        LAS float* scr = (LAS float*)(L + wave * 16384);
        if (wave < 3) {
            const int a = wave * 256 + (vcu & 255), cb = a % 48, kc = a / 48, k0 = kc * 128;
            if (a < 768 && vcu < 256) {
                const float* cp = arg_in(7); const float* cs = arg_in(8);
#pragma unroll
                for (int hh = 0; hh < 2; ++hh)
#pragma unroll 4
                    for (int r = 0; r < 24; ++r) { const float c = *(const float*)((const char*)((r < 8 ? cp + r * DM : cs + (r - 8) * DM) + k0 + hh * 64) + (unsigned)lane * 4u);
                        scr[(hh * 64 + lane) * 24 + r] = c * sigmoid_f(c); }
                LDS_WAIT(); asm volatile("" ::: "memory");
                f32x4 acc[24];
#pragma unroll
                for (int r = 0; r < 24; ++r) acc[r] = (f32x4){0.f, 0.f, 0.f, 0.f};
                const char* wpu = (const char*)(arg_in(9) + (size_t)k0 * NADA + cb * 256); const unsigned lo4 = (unsigned)lane * 4u;
#define ADA_LD(dst, kk) do { _Pragma("unroll") for (int q_ = 0; q_ < 4; ++q_) { const float* wp_ = (const float*)(wpu + (size_t)((kk) + q_) * (NADA * 4) + lo4); \
                    dst[q_][0] = wp_[0]; dst[q_][1] = wp_[64]; dst[q_][2] = wp_[128]; dst[q_][3] = wp_[192]; } } while (0)
#define ADA_FMA(src, kk) do { _Pragma("unroll") for (int q_ = 0; q_ < 4; ++q_) { const LAS f32x4* sp = (const LAS f32x4*)(scr + ((kk) + q_) * 24); \
                    _Pragma("unroll") for (int q = 0; q < 6; ++q) { const f32x4 s4 = sp[q]; \
                        acc[4 * q] += src[q_] * s4[0]; acc[4 * q + 1] += src[q_] * s4[1]; acc[4 * q + 2] += src[q_] * s4[2]; acc[4 * q + 3] += src[q_] * s4[3]; } } } while (0)
                f32x4 wa[4], wb[4];
                ADA_LD(wa, 0);
#pragma unroll 1
                for (int kl = 0; kl < 128; kl += 8) {
                    ADA_LD(wb, kl + 4);
                    ADA_FMA(wa, kl);
                    if (kl + 8 < 128) ADA_LD(wa, kl + 8);
                    ADA_FMA(wb, kl + 4);
                }
#undef ADA_LD
#undef ADA_FMA
                const float* ba = arg_in(10) + cb * 256 + lane;
#pragma unroll
                for (int r = 0; r < 24; ++r)
#pragma unroll
                    for (int e = 0; e < 4; ++e) unsafeAtomicAdd(mod + (size_t)r * NADA + cb * 256 + e * 64 + lane, acc[r][e] + (kc == 0 ? ba[e * 64] : 0.f));
                LDS_WAIT(); asm volatile("" ::: "memory");
            }
        }
        {
            constexpr int NIT0 = 10240;
            const int nper = (NIT0 + G - 1) / G;
            const int jsplit = (nper * 116) / 122;
            int j, jend, jstep;
            if (wave >= 3) { j = wave - 3; jend = jsplit; jstep = 5; } else { j = jsplit + wave; jend = nper; jstep = 3; }
            for (; j < jend; j += 2 * jstep) {
                const int it0 = vcu + G * j, it1 = vcu + G * (j + jstep);
                if (it0 >= NIT0) break;
                const bool two = (j + jstep < jend) && it1 < NIT0;
                const TItem t0 = titem_decode(it0, ws), t1 = titem_decode(two ? it1 : it0, ws);
                f32x4 b0[8], b1[8];
                titem_load(t0, b0, lane); if (two) titem_load(t1, b1, lane);
                titem_store(t0, b0, scr, lane); if (two) titem_store(t1, b1, scr, lane);
            }
        }
    }
    SEAM(0);

#define ROW_ISBF(MODE_, m_) ((MODE_) != 0 && (m_) < MP)
#define ROW_SRC(MODE_, m_) ((MODE_) == 0 ? ((m_) < MP ? arg_in(0) + (size_t)(m_) * DM : arg_in(1) + (size_t)((m_) - MP) * DM) : out + O_YP + (size_t)(m_) * DM)
#define ROW_LOAD(MODE_, m_, vf_, vb_) do { if (ROW_ISBF(MODE_, m_)) { const GAS u32x2* xb_ = (const GAS u32x2*)(X1B + (size_t)(m_) * DM) + lane; _Pragma("unroll") for (int j = 0; j < 8; ++j) vb_[j] = xb_[64 * j]; } \
        else { const GAS f32x4* xr_ = (const GAS f32x4*)ROW_SRC(MODE_, m_) + lane; _Pragma("unroll") for (int j = 0; j < 8; ++j) vf_[j] = xr_[64 * j]; } } while (0)
#define ROW_CVT(MODE_, m_, dst_, vf_, vb_) do { if (ROW_ISBF(MODE_, m_)) { _Pragma("unroll") for (int j = 0; j < 8; ++j) dst_[j] = (f32x4){bf_lo(vb_[j].x), bf_hi(vb_[j].x), bf_lo(vb_[j].y), bf_hi(vb_[j].y)}; } \
        else { _Pragma("unroll") for (int j = 0; j < 8; ++j) dst_[j] = vf_[j]; } } while (0)
#define ROWNORM(MODE_) do { TIDS();                                                                                                         \
        const float* gv = arg_in((MODE_) == 0 ? 11 : ((MODE_) == 1 ? 18 : 22));                                                            \
        const int nrow = (NGW == 2048) ? 16 + (gw < MS ? 1 : 0) : 0;                         \
        f32x4 v[8], vn[8], ga[8], gb[8]; u32x2 vb[8]; int cur_rb = -1;                                                                      \
        if ((MODE_) == 2) { _Pragma("unroll") for (int j = 0; j < 8; ++j) ga[j] = ((const f32x4*)gv)[64 * j + lane]; }                     \
        if (nrow > 0) { ROW_LOAD(MODE_, 16 * gw, vn, vb); ROW_CVT(MODE_, 16 * gw, v, vn, vb); }                                             \
        for (int k = 0; k < nrow; ++k) { const int m = k < 16 ? 16 * gw + k : MP + gw, mnx = k + 1 < 16 ? 16 * gw + k + 1 : MP + gw;        \
            if (k + 1 < nrow) ROW_LOAD(MODE_, mnx, vn, vb);                                                                                 \
            const int rb = m < MP ? (m >> 12) : NB_P + ((m - MP) >> 5);                                                                     \
            if ((MODE_) != 2 && rb != cur_rb) { cur_rb = rb; const float* shp = mod + (size_t)rb * NADA + ((MODE_) == 0 ? 0 : 3 * DM);      \
                _Pragma("unroll") for (int j = 0; j < 8; ++j) { ga[j] = ((const f32x4*)gv)[64 * j + lane] * (1.0f + ((const f32x4*)(shp + DM))[64 * j + lane]); gb[j] = ((const f32x4*)shp)[64 * j + lane]; } } \
            if ((MODE_) != 0 && m >= MP) { const int ns_ = (MODE_) == 1 ? 8 : 11; const float* sl_ = (const float*)(ws + ((MODE_) == 1 ? WS_SLAB5 : WS_SLAB8)) + (size_t)(m - MP) * DM; \
                _Pragma("unroll") for (int j = 0; j < 8; ++j) { f32x4 t_[11]; _Pragma("unroll") for (int sp = 0; sp < 11; ++sp) if (sp < ns_) t_[sp] = ((const GAS f32x4*)(sl_ + (size_t)sp * MS * DM) + lane)[64 * j]; \
                    _Pragma("unroll") for (int sp = 0; sp < 11; ++sp) if (sp < ns_) v[j] += t_[sp]; }                                      \
                if ((MODE_) == 1) { _Pragma("unroll") for (int j = 0; j < 8; ++j) *((GAS f32x4*)(out + O_YP + (size_t)m * DM) + 64 * j + lane) = v[j]; } }   \
            float s = 0.f;                                                                                                                  \
            _Pragma("unroll") for (int j = 0; j < 8; ++j) s += (v[j].x * v[j].x + v[j].y * v[j].y) + (v[j].z * v[j].z + v[j].w * v[j].w);   \
            const float rstd = 1.0f / sqrtf(wave_sum(s) * (1.0f / DM) + RMS_EPS);                                                           \
            _Pragma("unroll") for (int j = 0; j < 8; ++j) {                                                                                 \
                if ((MODE_) == 0 && m >= MP) *((GAS f32x4*)(out + O_YP + (size_t)m * DM) + 64 * j + lane) = v[j];                          \
                if ((MODE_) != 2) { const f32x4 hv = (v[j] * rstd) * ga[j] + gb[j]; v[j] = hv;                                              \
                    u32x2 w; w.x = cvt_pk_bf16(hv.x, hv.y); w.y = cvt_pk_bf16(hv.z, hv.w);                                                  \
                    *((GAS u32x2*)(Hb + (size_t)m * DM) + 64 * j + lane) = w;                                                               \
                    if ((MODE_) == 0) *((GAS unsigned*)(ws + WS_H8 + (size_t)m * DM) + 64 * j + lane) = cvt_pk4_fp8(hv.x * H_SCALE, hv.y * H_SCALE, hv.z * H_SCALE, hv.w * H_SCALE); } \
                else { *((GAS f32x4*)(out + O_YP + (size_t)m * DM) + 64 * j + lane) = (v[j] * rstd) * ga[j]; } }                            \
            if ((MODE_) == 0) {                                                                                                             \
                float fa[8];                                                                                                                \
                _Pragma("unroll") for (int jh = 0; jh < 8; ++jh) { float a = 0.f;                                                           \
                    _Pragma("unroll") for (int j = 0; j < 8; ++j) { const f32x4 w4 = ((const LAS f32x4*)(L + jh * 8192))[64 * j + lane];    \
                        a += (v[j].x * w4.x + v[j].y * w4.y) + (v[j].z * w4.z + v[j].w * w4.w); }                                           \
                    fa[jh] = wave_sum(a); }                                                                                                 \
                float f = fa[0];                                                                                                            \
                _Pragma("unroll") for (int jh = 1; jh < 8; ++jh) f = (lane == jh) ? fa[jh] : f;                                             \
                if (lane < 8) { const float lf = log_sigmoid_f(f + arg_in(13)[lane]);                                                      \
                    if (m < MP) out[O_FLP + (size_t)m * 8 + lane] = lf; else out[O_FLS + (size_t)(m - MP) * 8 + lane] = lf; } }             \
            if (k + 1 < nrow) ROW_CVT(MODE_, mnx, v, vn, vb);                                                                               \
        } } while (0)
    if (IN(1)) for (int rep = 0; rep < NREP(1); ++rep) {
        { TIDS(); for (int k = tid; k < DM; k += NTHREADS) { const float* p = arg_in(12) + (size_t)k * NIN_SRC + 3072;
            const f32x4 a = *(const f32x4*)p, b = *(const f32x4*)(p + 4);
            LAS float* w = (LAS float*)L + k;
            w[0] = a.x; w[2048] = a.y; w[4096] = a.z; w[6144] = a.w; w[8192] = b.x; w[10240] = b.y; w[12288] = b.z; w[14336] = b.w; } }
        __syncthreads();
        ROWNORM(0);
        __syncthreads();
    }
    SEAM(1);

    if (IN(2)) for (int rep = 0; rep < NREP(2); ++rep) {
        if (bx >= 64 && bx < 256) {
            TIDS();
            const int sid = bx - 64;
            LAS float* wtot = (LAS float*)L;
            const bool smp = sid >= 64; const int bh = smp ? sid - 64 : sid, b = bh >> 3, h = bh & 7;
            const float* src = smp ? arg_in(4) + ((size_t)b * PAST) * 8 + h : out + O_FLP + ((size_t)b * SEQ) * 8 + h;
            float v[8];
#pragma unroll
            for (int j = 0; j < 8; ++j) v[j] = src[(size_t)(tid * 8 + j) * 8];
#pragma unroll
            for (int j = 1; j < 8; ++j) v[j] += v[j - 1];
            float incl = v[7];
#pragma unroll
            for (int o = 1; o < 64; o <<= 1) { const float t = __shfl_up(incl, o); if (lane >= o) incl += t; }
            if (lane == 63) wtot[wave] = incl;
            __syncthreads();
            float base = incl - v[7];
            for (int w = 0; w < wave; ++w) base += wtot[w];
            float* dst = fneg + (size_t)sid * FNEG_LD;
#pragma unroll
            for (int j = 0; j < 8; ++j) dst[tid * 8 + j] = -(base + v[j]) * att::INV_SCALE;
            if (smp && wave == 0) {
                float tot = 0.f;
                for (int w = 0; w < 8; ++w) tot += wtot[w];
                float x = lane < TS ? out[O_FLS + ((size_t)b * TS + lane) * 8 + h] : 0.f;
#pragma unroll
                for (int o = 1; o < 64; o <<= 1) { const float t = __shfl_up(x, o); if (lane >= o) x += t; }
                dst[PAST + lane] = lane < TS ? -(tot + x) * att::INV_SCALE : 0.f;
            }
            __syncthreads();
        }
        {
            pg8::Gemm g{Hb, (const bf16*)(ws + WS_WIN), nullptr, nullptr, DM};
            pg8::StaticOrder S; S.init(NMT, 16, G, bx, 0, DM / 64);
            pg8::EpiInProj<false> E{QKV, ZA, ZB, out};
            pg8::gemm_phase<pg8::EpiInProj<false>>(L, g, S, E, wave);
        }
        {
            pg8::Gemm g{(const bf16*)(ws + WS_H8), (const bf16*)(ws + WS_WIN8), nullptr, nullptr, DM};
            pg8::StaticOrder S; S.init(NMT, 24, G, bx, 0, DM / 128); S.skew = 32; S.nfull = 11;
            pg8::EpiInProj<true> E{QKV, ZA, ZB, out};
            pg8::gemm_phase<pg8::EpiInProj<true>, true, true>(L, g, S, E, wave);
        }
    }
    SEAM(2);

    if (IN(3)) for (int rep = 0; rep < NREP(3); ++rep) {
        char* al = (char*)lds;
        LAS float* FL = (LAS float*)(L + att::OFF_FL);
        LAS float* TB = (LAS float*)(L + att::OFF_TB);
        volatile LAS int* QW = (volatile LAS int*)(L + att::OFF_QW);
        bf16* QAb = QKV; bf16* KAb = QKV + QKV_STRIDE; bf16* VAb = QKV + 2 * QKV_STRIDE; bf16* QBb = QKV + 3 * QKV_STRIDE; bf16* KBb = QKV + 4 * QKV_STRIDE; bf16* VBb = QKV + 5 * QKV_STRIDE;
        unsigned char* OA8 = (unsigned char*)Hb; unsigned char* OB8 = OA8 + QKV_STRIDE_B;
        const float* rel = arg_in(14);
        att::Seam S;
        if (vcu < 256) {
            const int u = vcu >> 1, b = u >> 3, h = u & 7;
            if ((vcu & 1) == 0) {
                att::foxs_unit(QAb + (size_t)(MP + b * TS) * DH + h * HD, (bf16*)(OA8 + (size_t)(MP + b * TS) * DH + h * HD),
                               arg_in(2) + ((size_t)b * PAST * NH + h) * HD, arg_in(3) + ((size_t)b * PAST * NH + h) * HD,
                               out + O_FKS + (size_t)(b * TS) * DH + h * HD, out + O_FVS + (size_t)(b * TS) * DH + h * HD,
                               fneg + (size_t)(64 + u) * FNEG_LD, al, wave);
            } else {
                const float t256 = rel[256 * NH + h];
                { TIDS(); for (int i = tid; i < 257; i += NTHREADS) TB[i] = (rel[i * NH + h] - t256) * att::INV_SCALE; }
                att::Job J; J.Q = QBb + (size_t)(MP + b * TS) * DH + h * HD; J.O = (bf16*)(OB8 + (size_t)(MP + b * TS) * DH + h * HD);
                J.K = arg_in(5) + ((size_t)b * LBAND * NH + h) * HD; J.V = arg_in(6) + ((size_t)b * LBAND * NH + h) * HD;
                J.Kn = out + O_BKS + (size_t)(b * TS) * DH + h * HD; J.Vn = out + O_BVS + (size_t)(b * TS) * DH + h * HD;
                J.P0 = LBAND; J.j_lo = 0; J.j_hi = LBAND / 64 + 1;
                att::attn_prime<att::BANDS>(J, al, S, wave);
                att::attn_block<att::BANDS>(J, J, al, S, wave);
            }
        }
        __syncthreads();
        if (vcu < 256) {
            const int bh = vcu >> 2, gq = vcu & 3, b = bh >> 3, h = bh & 7;
            const float* fsrc = fneg + (size_t)bh * FNEG_LD;
            const size_t hb = (size_t)(b * SEQ) * DH + h * HD;
            LAS float* red = (LAS float*)(L + att::OFF_QW + 64);
            float kmax2, qmax2[4];
            { TIDS(); for (int i = tid; i < SEQ / 4; i += NTHREADS) ((LAS f32x4*)FL)[i] = ((const f32x4*)fsrc)[i];
              const int sub = lane & 15, ro = tid >> 4;
#define ROWSS(p_) ({ const u32x4 w_ = *(const u32x4*)(p_); float s_ = bf_lo(w_.x) * bf_lo(w_.x) + bf_hi(w_.x) * bf_hi(w_.x); s_ += bf_lo(w_.y) * bf_lo(w_.y) + bf_hi(w_.y) * bf_hi(w_.y); \
                  s_ += bf_lo(w_.z) * bf_lo(w_.z) + bf_hi(w_.z) * bf_hi(w_.z); s_ += bf_lo(w_.w) * bf_lo(w_.w) + bf_hi(w_.w) * bf_hi(w_.w); \
                  s_ += __builtin_bit_cast(float, __builtin_amdgcn_update_dpp(0, __builtin_bit_cast(int, s_), 0xB1, 0xF, 0xF, true));      \
                  s_ += __builtin_bit_cast(float, __builtin_amdgcn_update_dpp(0, __builtin_bit_cast(int, s_), 0x4E, 0xF, 0xF, true));      \
                  s_ += __builtin_bit_cast(float, __builtin_amdgcn_update_dpp(0, __builtin_bit_cast(int, s_), 0x141, 0xF, 0xF, true));     \
                  s_ += __builtin_bit_cast(float, __builtin_amdgcn_update_dpp(0, __builtin_bit_cast(int, s_), 0x140, 0xF, 0xF, true));     \
                  s_; })
#define WGMAX(v_) ({ float m_ = (v_); _Pragma("unroll") for (int o_ = 1; o_ < 64; o_ <<= 1) m_ = fmaxf(m_, __shfl_xor(m_, o_)); if (lane == 0) red[wave] = m_; __syncthreads(); \
                  float r_ = red[0]; _Pragma("unroll") for (int w_ = 1; w_ < 8; ++w_) r_ = fmaxf(r_, red[w_]); __syncthreads(); r_; })
              float km = 0.f; const bf16* Kp = KAb + hb + sub * 8;
#pragma unroll 8
              for (int sr_ = ro; sr_ < SEQ; sr_ += 32) km = fmaxf(km, ROWSS(Kp + (size_t)sr_ * DH));
              kmax2 = WGMAX(km);
#pragma unroll
              for (int i = 0; i < 4; ++i) { const int qb = (i == 0) ? 15 - gq : (i == 1) ? 8 + gq : (i == 2) ? 7 - gq : gq; float qm = 0.f; const bf16* Qp = QAb + hb + (size_t)(qb * 256) * DH + sub * 8;
#pragma unroll
                  for (int sr_ = ro; sr_ < 256; sr_ += 32) qm = fmaxf(qm, ROWSS(Qp + (size_t)sr_ * DH));
                  qmax2[i] = WGMAX(qm); }
#undef ROWSS
#undef WGMAX
            }
            att::Job J[4];
#pragma unroll
            for (int i = 0; i < 4; ++i) { const int qb = (i == 0) ? 15 - gq : (i == 1) ? 8 + gq : (i == 2) ? 7 - gq : gq;
                const float thr = 32.0f * att::INV_SCALE + 2.0f * sqrtf(qmax2[i] * kmax2) * 1.001f + 1.0f;
                const float f0 = FL[qb * 256]; int jl = 0;
                for (int j = 0; j < 4 * qb; ++j) jl += (FL[64 * j + 63] - f0 <= -thr) ? 1 : 0;
                jl = __builtin_amdgcn_readfirstlane(jl);
                J[i].Q = QAb + hb + (size_t)(qb * 256) * DH; J[i].O = (bf16*)(OA8 + hb + (size_t)(qb * 256) * DH); J[i].K = KAb + hb; J[i].V = VAb + hb; J[i].Kn = nullptr; J[i].Vn = nullptr;
                J[i].P0 = qb * 256; J[i].j_lo = jl; J[i].j_hi = 4 * (qb + 1); }
            att::attn_prime<att::FOXP>(J[0], al, S, wave);
            att::attn_block<att::FOXP>(J[0], J[1], al, S, wave);
            att::attn_block<att::FOXP>(J[1], J[2], al, S, wave);
            att::attn_block<att::FOXP>(J[2], J[3], al, S, wave);
            att::attn_block<att::FOXP>(J[3], J[3], al, S, wave);
        }
        __syncthreads();
#define BJOB(J_, hb_, g_) do { (J_).Q = QBb + (hb_) + (size_t)((g_) * 256) * DH; (J_).O = (bf16*)(OB8 + (hb_) + (size_t)((g_) * 256) * DH); (J_).K = KBb + (hb_); (J_).V = VBb + (hb_); \
        (J_).Kn = nullptr; (J_).Vn = nullptr; (J_).P0 = (g_) * 256; (J_).j_lo = (4 * (g_) - 8) > 0 ? 4 * (g_) - 8 : 0; (J_).j_hi = 4 * (g_) + 4; } while (0)
        if (vcu < 256) {
            const int bh = vcu >> 2, gsel = vcu & 3, b = bh >> 3, h = bh & 7;
            const int g0 = gsel == 0 ? 7 : gsel == 1 ? 2 : gsel == 2 ? 14 : 9, nb = (gsel & 1) ? 5 : 2;
            const float t256 = rel[256 * NH + h];
            { TIDS(); for (int i = tid; i < 257; i += NTHREADS) TB[i] = (rel[i * NH + h] - t256) * att::INV_SCALE; }
            const size_t hb = (size_t)(b * SEQ) * DH + h * HD;
            att::Job J, Jn; BJOB(J, hb, g0);
            att::attn_prime<att::BANDP>(J, al, S, wave);
            for (int k = 0; k < nb; ++k) { const int gn = g0 + (k + 1 < nb ? k + 1 : k); BJOB(Jn, hb, gn);
                att::attn_block<att::BANDP>(J, Jn, al, S, wave); J = Jn; }
        }
        __syncthreads();
        for (;;) {
            if (wave == 0 && lane_id() == 0) QW[0] = (int)__hip_atomic_fetch_add((unsigned*)(ctl + CW_Q + 64 * rep), 1u, RLX_AGENT);
            __syncthreads();
            const int v = QW[0];
            if (v >= 128) break;
            const int gq = 1 - (v >> 6), bh = v & 63, b = bh >> 3, h = bh & 7;
            const float t256 = rel[256 * NH + h];
            { TIDS(); for (int i = tid; i < 257; i += NTHREADS) TB[i] = (rel[i * NH + h] - t256) * att::INV_SCALE; }
            const size_t hb = (size_t)(b * SEQ) * DH + h * HD;
            att::Job J; BJOB(J, hb, gq);
            att::attn_prime<att::BANDP>(J, al, S, wave);
            att::attn_block<att::BANDP>(J, J, al, S, wave);
        }
        __syncthreads();
#undef BJOB
        {
            LAS float* scr = (LAS float*)(L + wave * 16384); const int lane = lane_id();
            for (;;) {
                int it = 0; if (lane == 0) it = (int)__hip_atomic_fetch_add((unsigned*)(ctl + CW_Q + 1024), 2u, RLX_AGENT);
                it = __builtin_amdgcn_readfirstlane(it) + 10240;
                if (it >= 31232) break;
                const TItem t0 = titem_decode(it, ws), t1 = titem_decode(it + 1, ws);
                f32x4 b0[8], b1[8];
                titem_load(t0, b0, lane); titem_load(t1, b1, lane);
                titem_store(t0, b0, scr, lane); titem_store(t1, b1, scr, lane);
            }
        }
        __syncthreads();
    }
    SEAM(3);

    if (IN(4)) {
        pg8::Gemm g{Hb, (const bf16*)(ws + WS_WOA), Hb + QKV_STRIDE, (const bf16*)(ws + WS_WOB), DH};
        pg8::StaticOrder S; S.init(MP / 256, DM / 256, G, bx, 1, DH / 128, 64, 4, 4, MP / 256, 1);
        pg8::EpiMerge E{ZA, ZB, (float*)(ws + WS_SLAB4), ws + WS_M8};
        pg8::gemm_phase<pg8::EpiMerge, true, true>(L, g, S, E, wave);
    }
    SEAM(4);
    if (IN(5)) {
        TIDS();
        if (gw < MS) { const float* sl = (const float*)(ws + WS_SLAB4) + (size_t)gw * DM;
#pragma unroll
            for (int j = 0; j < 8; ++j) { f32x4 t = ((const GAS f32x4*)sl + lane)[64 * j];
#pragma unroll
                for (int sp = 1; sp < 4; ++sp) t += ((const GAS f32x4*)(sl + (size_t)sp * MS * DM) + lane)[64 * j];
                *((GAS unsigned*)(ws + WS_M8 + (size_t)(MP + gw) * DM) + 64 * j + lane) = cvt_pk4_fp8(t.x * M_SCALE, t.y * M_SCALE, t.z * M_SCALE, t.w * M_SCALE); } }
        if (IN(4)) xcd_barrier(bar, wave);
    }
    if (IN(5)) for (int rep = 0; rep < NREP(5); ++rep) {
        pg8::Gemm g{(const bf16*)(ws + WS_M8), (const bf16*)(ws + WS_WOUT), nullptr, nullptr, DM};
        pg8::StaticOrder S; S.init(MP / 256, DM / 256, G, bx, 0, DM / 128, 128, 8, 2, MP / 256);
        pg8::EpiResid<true> E{arg_in(0), X1B, mod + 2 * DM, (float*)(ws + WS_SLAB5)};
        pg8::gemm_phase<pg8::EpiResid<true>, true, true>(L, g, S, E, wave);
    }
    SEAM(5);
    if (IN(6)) for (int rep = 0; rep < NREP(6); ++rep) { ROWNORM(1); }
    SEAM(6);
    if (IN(7)) for (int rep = 0; rep < NREP(7); ++rep) {
        pg8::Gemm g{Hb, (const bf16*)(ws + WS_WGU), nullptr, nullptr, DM};
        pg8::StaticOrder S; S.init(NMT, 2 * DFF / 256, G, bx, 0, DM / 64);
        pg8::EpiSwiglu E{ACT};
        pg8::gemm_phase<pg8::EpiSwiglu>(L, g, S, E, wave);
    }
    SEAM(7);
    if (IN(8)) {
        pg8::Gemm g{ACT, (const bf16*)(ws + WS_WDN), nullptr, nullptr, DFF};
        pg8::StaticOrder S; S.init(MP / 256, DM / 256, G, bx, 0, DFF / 128, 176, 11, 4, MP / 256);
        pg8::EpiResid<false> E{arg_in(0), X1B, mod + 5 * DM, (float*)(ws + WS_SLAB8)};
        pg8::gemm_phase<pg8::EpiResid<false>, true, true>(L, g, S, E, wave);
    }
    SEAM(8);
    if (IN(9)) { ROWNORM(2); }
#undef IN
#undef SEAM
#undef ROWNORM
#undef ROW_SRC
#undef ROW_ISBF
#undef ROW_LOAD
#undef ROW_CVT
}

extern "C" void kernel_launch(void* const* d_in, const int* in_sizes, int n_in, void* d_out, int out_size, void* d_ws, size_t ws_size, hipStream_t stream) {
    static int grid = 0;
    if (grid == 0) {
        if (n_in != 23 || in_sizes[0] != MP * DM || (size_t)out_size != O_TOTAL || ws_size < WS_END) {
            fprintf(stderr, "kernel_launch: shape mismatch (n_in %d, in0 %d, out %d, ws %zu); nothing launched\n", n_in, n_in > 0 ? in_sizes[0] : -1, out_size, ws_size); grid = -1; return; }
        int dev = 0, cus = 0, per_cu = 0;
        if (hipGetDevice(&dev) != hipSuccess || hipDeviceGetAttribute(&cus, hipDeviceAttributeMultiprocessorCount, dev) != hipSuccess) { fprintf(stderr, "kernel_launch: device query failed\n"); grid = -1; return; }
        if (hipFuncSetAttribute((const void*)fwd_kernel, hipFuncAttributeMaxDynamicSharedMemorySize, LDS_BYTES) != hipSuccess) { fprintf(stderr, "kernel_launch: hipFuncSetAttribute failed\n"); grid = -1; return; }
        if (hipOccupancyMaxActiveBlocksPerMultiprocessor(&per_cu, (const void*)fwd_kernel, NTHREADS, LDS_BYTES) != hipSuccess || per_cu < 1)
            fprintf(stderr, "kernel_launch: note: occupancy query reports %d workgroups per CU\n", per_cu);
        (void)hipGetLastError();
        grid = cus < 256 ? cus : 256;
    }
    if (grid < 0) return;
    Args a{};
    for (int i = 0; i < 23; ++i) a.in[i] = (const float*)d_in[i];
    a.out = (float*)d_out; a.ws = (unsigned char*)d_ws;
    if (PROBE_PREFIX >= 0) { (void)hipMemsetAsync((char*)d_ws + WS_CTL, 0, ZERO_BYTES, stream); a.ph_lo = 0; a.ph_hi = PROBE_PREFIX + 1;
        hipLaunchKernelGGL(fwd_kernel, dim3(grid), dim3(NTHREADS), LDS_BYTES, stream, a); }
    if (hipMemsetAsync((char*)d_ws + WS_CTL, 0, ZERO_BYTES, stream) != hipSuccess) { fprintf(stderr, "kernel_launch: memset failed\n"); return; }
    if (MK_N_LAUNCHES == 1) { a.ph_lo = 0; a.ph_hi = 10; hipLaunchKernelGGL(fwd_kernel, dim3(grid), dim3(NTHREADS), LDS_BYTES, stream, a); }
    else for (int p = 0; p < 10; ++p) { a.ph_lo = p; a.ph_hi = p + 1; hipLaunchKernelGGL(fwd_kernel, dim3(grid), dim3(NTHREADS), LDS_BYTES, stream, a); }
    const hipError_t le = hipPeekAtLastError();
    if (le != hipSuccess) fprintf(stderr, "kernel_launch: launch failed: %s\n", hipGetErrorName(le));
}
```

```cpp
#include <hip/hip_runtime.h>
#include <hip/hip_bf16.h>
#include <cstdio>
#include <cstdint>

#ifndef MK_N_LAUNCHES
#define MK_N_LAUNCHES 1
#endif

#ifndef REPEAT_MASK
#define REPEAT_MASK 0
#endif
#define NREP(k) (1 + ((REPEAT_MASK >> (k)) & 1))
#ifndef PROBE_PREFIX
#define PROBE_PREFIX -1
#endif
constexpr int DM = 2048, MP = 32768, MS = 512, MROWS = MP + MS, SEQ = 4096, NB_P = 8, NB_S = 16, TS = 32;
constexpr int NH = 8, HD = 128, DH = NH * HD  , DFF = 5632, NIN_SRC = 10248, NIN = 10240, NADA = 6 * DM;
constexpr int PAST = 4096, LBAND = 512;
constexpr float RMS_EPS = 1e-6f;
constexpr int NMT = MROWS / 256;
constexpr size_t O_YP = 0, O_YS = 67108864, O_FKP = 68157440, O_FVP = 101711872, O_FLP = 135266304, O_BKP = 135528448, O_BVP = 139722752,
                 O_FKS = 143917056, O_FVS = 144441344, O_FLS = 144965632, O_BKS = 144969728, O_BVS = 145494016, O_TOTAL = 146018304;
constexpr size_t MiB = 1u << 20;
constexpr size_t WS_CTL = 0, WS_MOD = 1 * MiB, ZERO_BYTES = 2 * MiB + 256 * 1024, WS_FNEG = 3 * MiB;
constexpr size_t WS_WIN = 8 * MiB, WS_WOA = 48 * MiB, WS_WOB = 52 * MiB, WS_WOUT = 56 * MiB, WS_WGU = 64 * MiB, WS_WDN = 108 * MiB;
constexpr size_t WS_H = 130 * MiB, WS_QKV = 260 * MiB, QKV_STRIDE_B = 65 * MiB, WS_ZA = 650 * MiB, WS_ZB = 780 * MiB, WS_H8 = 910 * MiB, WS_WIN8 = 975 * MiB, WS_END = 1000 * MiB;
constexpr size_t WS_SLAB4 = WS_QKV + QKV_STRIDE_B, WS_SLAB5 = WS_QKV, WS_SLAB8 = WS_ZA;
constexpr size_t _ws_slab_doc = 0;
constexpr size_t WS_M8 = WS_QKV + 2 * QKV_STRIDE_B;
constexpr size_t WS_ACT = WS_QKV, WS_T = WS_QKV + QKV_STRIDE_B;
constexpr size_t QKV_STRIDE = QKV_STRIDE_B / 2;
static_assert((size_t)MROWS * DH * 2 == QKV_STRIDE_B && (size_t)MROWS * DM * 2 == 130 * MiB && (size_t)MROWS * DFF * 2 <= 6 * QKV_STRIDE_B, "ws map");
constexpr int FNEG_LD = 4160;
constexpr int CW_TMO = 0, CW_BAR = 4096, CW_Q = 8192;
constexpr int NWAVES = 8, NTHREADS = 512;
constexpr int RING_BYTES = 131072, LDSCTL_OFF = RING_BYTES, MISC_OFF = LDSCTL_OFF + 320, LDS_BYTES = 147456;

#define GAS __attribute__((address_space(1)))
#define LAS __attribute__((address_space(3)))
typedef unsigned short bf16;
typedef unsigned v4u __attribute__((ext_vector_type(4)));
typedef float f32x4 __attribute__((ext_vector_type(4)));
typedef float f32x2 __attribute__((ext_vector_type(2)));
typedef float f32x16 __attribute__((ext_vector_type(16)));
typedef short bf16x8 __attribute__((ext_vector_type(8)));
typedef short s16x4 __attribute__((ext_vector_type(4)));
typedef unsigned u32x4 __attribute__((ext_vector_type(4)));
typedef unsigned u32x2 __attribute__((ext_vector_type(2)));
typedef GAS unsigned gu32;
#define RLX_AGENT __ATOMIC_RELAXED, __HIP_MEMORY_SCOPE_AGENT
#define LDS_WAIT() asm volatile("s_waitcnt lgkmcnt(0)" ::: "memory")
#define VM_WAIT() asm volatile("s_waitcnt vmcnt(0)" ::: "memory")

__device__ __forceinline__ unsigned cvt_pk_bf16(float lo, float hi) { unsigned r; asm volatile("s_nop 1\n\tv_cvt_pk_bf16_f32 %0, %1, %2" : "=v"(r) : "v"(lo), "v"(hi)); return r; }
__device__ __forceinline__ float fp8_clamp(float x) { return __builtin_amdgcn_fmed3f(x, -448.0f, 448.0f); }
__device__ __forceinline__ unsigned cvt_pk4_fp8(float a, float b, float c, float d) { int w = __builtin_amdgcn_cvt_pk_fp8_f32(fp8_clamp(a), fp8_clamp(b), 0, false); w = __builtin_amdgcn_cvt_pk_fp8_f32(fp8_clamp(c), fp8_clamp(d), w, true); return (unsigned)w; }
constexpr float H_SCALE = 8.0f, WIN_SCALE = 32.0f;
constexpr float O_SCALE = 16.0f, WO_SCALE = 16.0f;
constexpr float G_SCALE = 256.0f;
__device__ __forceinline__ void fp8x8_to_f32(u32x2 w, f32x4& lo, f32x4& hi) {
    typedef float f32x2_ __attribute__((ext_vector_type(2)));
    const f32x2_ a = __builtin_amdgcn_cvt_pk_f32_fp8((int)w.x, false), b = __builtin_amdgcn_cvt_pk_f32_fp8((int)w.x, true);
    const f32x2_ c = __builtin_amdgcn_cvt_pk_f32_fp8((int)w.y, false), d = __builtin_amdgcn_cvt_pk_f32_fp8((int)w.y, true);
    lo = (f32x4){a.x, a.y, b.x, b.y}; hi = (f32x4){c.x, c.y, d.x, d.y};
}
constexpr float WOUT_SCALE = 32.0f, M_SCALE = 16.0f;
constexpr float WDN_SCALE = 64.0f;
__device__ __forceinline__ float bf_lo(unsigned w) { return __uint_as_float(w << 16); }
__device__ __forceinline__ float bf_hi(unsigned w) { return __uint_as_float(w & 0xffff0000u); }
__device__ __forceinline__ float sigmoid_f(float v) { return __builtin_amdgcn_rcpf(1.0f + __builtin_amdgcn_exp2f(-1.4426950408889634f * v)); }
__device__ __forceinline__ int lane_id() { int l; asm volatile("v_mbcnt_lo_u32_b32 %0, -1, 0\n\tv_mbcnt_hi_u32_b32 %0, -1, %0" : "=v"(l)); return l; }
template <class T> __device__ __forceinline__ T* uni_ptr(T* p) {
    const unsigned long long v = (unsigned long long)p; const unsigned lo = __builtin_amdgcn_readfirstlane((unsigned)v), hi = __builtin_amdgcn_readfirstlane((unsigned)(v >> 32));
    return (T*)(((unsigned long long)hi << 32) | lo); }
__device__ __forceinline__ float wave_sum(float v) {
#pragma unroll
    for (int o = 1; o < 64; o <<= 1) v += __shfl_xor(v, o);
    return v;
}

namespace pg8 {
typedef unsigned short bf16_t;
constexpr int BM = 256, BK = 64, HALF = 128, HTB = HALF * BK * 2, STAGE_BYTES = 8 * HTB, NXCD = 8, WGM = 4;
__host__ __device__ __forceinline__ int lds_byte(int r, int c) { const int st = (r >> 4) * 2 + (c >> 5), rr = r & 15, cc = c & 31, ob = rr * 64 + cc * 2; return st * 1024 + (ob ^ (((ob >> 9) & 1) << 5)); }
__host__ __device__ __forceinline__ void stage_rc(int b, int& R, int& C) { const int st = b / 1024, sb = b % 1024, swz = sb ^ (((sb >> 9) & 1) << 5); R = (st >> 1) * 16 + swz / 64; C = (st & 1) * 32 + (swz % 64) / 2; }
__host__ __device__ __forceinline__ int perm32(int rho) { const int n = rho >> 4, i = rho & 15; return 8 * (i >> 2) + 4 * n + (i & 3); }

struct Unit { int pm, pn, sub, kt0, nkt, part; };
struct Gemm { const bf16_t* A; const bf16_t* Bt; const bf16_t* A2; const bf16_t* Bt2; int K; };

struct StaticOrder {
    int nM, nN, nwg, G, c, pair, nkt_full, nmini, nsplit, mini_nkt, mini_pm0, mini_pair, skew = 0, nfull = 0;
    __device__ void init(int nM_, int nN_, int G_, int c_, int pair_, int nkt_full_, int nmini_ = 0, int nsplit_ = 1, int mini_nkt_ = 0, int mini_pm0_ = 0, int mini_pair_ = 0) {
        mini_pair = mini_pair_; nM = nM_; nN = nN_; nwg = nM * nN; G = G_; c = c_; pair = pair_; nkt_full = nkt_full_; nmini = nmini_; nsplit = nsplit_; mini_nkt = mini_nkt_; mini_pm0 = mini_pm0_; }
    __device__ __forceinline__ bool next(int i, Unit& u) const {
        const bool hm = c < nmini, mini = hm && i == 0;
        int j = i - (hm ? 1 : 0); j = j < 0 ? 0 : j;
        const int ip = j >> pair;
        const bool sk = skew > 0 && ip >= nfull;
        const long L = sk ? (long)nfull * G + (long)(ip - nfull) * (G - skew) + (c - skew) : (long)ip * G + c; const bool ok = L < nwg && (!sk || c >= skew);
        int wgid = ok ? (int)L : 0; { const int q = nwg / NXCD, r = nwg % NXCD, xcd = wgid % NXCD, off = wgid / NXCD; wgid = (xcd < r ? xcd * (q + 1) : r * (q + 1) + (xcd - r) * q) + off; }
        const int nig = WGM * nN, gid = wgid / nig, fm = gid * WGM, gsz = (nM - fm) < WGM ? (nM - fm) : WGM;
        const int fpm = fm + ((wgid % nig) % gsz), fpn = (wgid % nig) / gsz;
        const int ns = nsplit > 0 ? nsplit : 1, t = c / ns, ks = c - t * ns, mpm = mini_pm0 + t / nN, mpn = t % nN;
        u.pm = __builtin_amdgcn_readfirstlane(mini ? mpm : fpm); u.pn = __builtin_amdgcn_readfirstlane(mini ? mpn : fpn);
        const int kh = mini_pair ? ns / 2 : ns, msub = mini_pair ? ks / kh : 0, mk = ks - msub * kh;
        u.sub = __builtin_amdgcn_readfirstlane(mini ? msub : (j & ((1 << pair) - 1))); u.kt0 = __builtin_amdgcn_readfirstlane(mini ? mk * mini_nkt : 0); u.nkt = mini ? mini_nkt : nkt_full; u.part = mini ? 1 + ks : 0;
        return mini || ok;
    }
};

typedef f32x4 Acc[2][2][4][2];

template <bool F8> struct EpiInProj {
    static constexpr bool PERM = true;
    static __device__ __forceinline__ int mapn(int pn) { return F8 ? pn + (pn >= 4 ? 8 : 0) + (pn >= 8 ? 8 : 0) : pn + 4 + (pn >= 8 ? 4 : 0); }
    static __device__ __forceinline__ bool keep(const Unit&) { return false; }
    bf16_t* qkv; bf16_t* za; bf16_t* zb; float* out;
    __device__ __forceinline__ void operator()(const Acc& acc, const Unit& u, int wr, int wc, int fr, int fq) const {
        const int pn = u.pn, pm = u.pm; const int rloc = wr * 64 + fr;
        constexpr float QS = F8 ? 1.0f / (H_SCALE * WIN_SCALE) : 1.0f;
        if (!F8 || pn < 24) {
            const int reg = pn >> 2, colt = (pn & 3) * 256 + wc * 32 + 8 * fq;
            bf16_t* base = qkv + (size_t)reg * QKV_STRIDE + (size_t)(pm * 256 + rloc) * DH + colt;
            float* fo = nullptr;
            if (!F8 && (reg == 1 || reg == 2 || reg == 4 || reg == 5)) {
                if (pm < 128) {
                    if (reg == 1) fo = out + O_FKP + (size_t)(pm * 256) * DH;
                    else if (reg == 2) fo = out + O_FVP + (size_t)(pm * 256) * DH;
                    else if ((pm & 15) >= 14) fo = out + (reg == 4 ? O_BKP : O_BVP) + ((size_t)(pm >> 4) * LBAND + (size_t)((pm & 15) - 14) * 256) * DH;
                } else {
                    const size_t ms0 = (size_t)(pm - 128) * 256 * DH;
                    fo = out + (reg == 1 ? O_FKS : reg == 2 ? O_FVS : reg == 4 ? O_BKS : O_BVS) + ms0;
                }
                if (fo) fo += (size_t)rloc * DH + colt;
            }
#pragma unroll
            for (int ai = 0; ai < 2; ++ai)
#pragma unroll
                for (int m = 0; m < 4; ++m) {
                    const size_t ro = (size_t)(ai * HALF + m * 16) * DH;
#pragma unroll
                    for (int bj = 0; bj < 2; ++bj) {
                        const f32x4 v0 = acc[ai][bj][m][0] * QS, v1 = acc[ai][bj][m][1] * QS;
                        u32x4 w; w.x = cvt_pk_bf16(v0[0], v0[1]); w.y = cvt_pk_bf16(v0[2], v0[3]); w.z = cvt_pk_bf16(v1[0], v1[1]); w.w = cvt_pk_bf16(v1[2], v1[3]);
                        *(u32x4*)(base + ro + bj * HALF) = w;
                        if (!F8 && fo) { *(f32x4*)(fo + ro + bj * HALF) = v0; *(f32x4*)(fo + ro + bj * HALF + 4) = v1; }
                    }
                }
        } else {
            unsigned char* base = (unsigned char*)(pn < 32 ? za : zb) + (size_t)(pm * 256 + rloc) * DM + ((pn - 24) & 7) * 256 + wc * 32 + 8 * fq;
#pragma unroll
            for (int ai = 0; ai < 2; ++ai)
#pragma unroll
                for (int m = 0; m < 4; ++m) {
                    const size_t ro = (size_t)(ai * HALF + m * 16) * DM;
#pragma unroll
                    for (int bj = 0; bj < 2; ++bj) {
                        const f32x4 v0 = acc[ai][bj][m][0] * QS, v1 = acc[ai][bj][m][1] * QS;
                        u32x2 w; w.x = cvt_pk4_fp8(sigmoid_f(v0[0]) * G_SCALE, sigmoid_f(v0[1]) * G_SCALE, sigmoid_f(v0[2]) * G_SCALE, sigmoid_f(v0[3]) * G_SCALE);
                        w.y = cvt_pk4_fp8(sigmoid_f(v1[0]) * G_SCALE, sigmoid_f(v1[1]) * G_SCALE, sigmoid_f(v1[2]) * G_SCALE, sigmoid_f(v1[3]) * G_SCALE);
                        *(u32x2*)(base + ro + bj * HALF) = w;
                    }
                }
        }
    }
};
struct EpiMerge {
    static constexpr bool PERM = true;
    static __device__ __forceinline__ int mapn(int pn) { return pn; }
    static __device__ __forceinline__ bool keep(const Unit& u) { return u.sub == 0 && u.part == 0; }
    bf16_t* za; const bf16_t* zb; float* slab; unsigned char* m8;
    __device__ __forceinline__ void operator()(Acc& acc, const Unit& u, int wr, int wc, int fr, int fq) const {
        if (u.part) {
            const unsigned char* sg = (const unsigned char*)(u.sub == 0 ? (const bf16_t*)za : zb) + (size_t)(u.pm * 256 + wr * 64 + fr) * DM + u.pn * 256 + wc * 32 + 8 * fq;
            float* sl = slab + ((size_t)(u.part - 1) * MS + (u.pm * 256 - MP) + wr * 64 + fr) * DM + u.pn * 256 + wc * 32 + 8 * fq;
#pragma unroll
            for (int ai = 0; ai < 2; ++ai)
#pragma unroll
                for (int m = 0; m < 4; ++m)
#pragma unroll
                    for (int bj = 0; bj < 2; ++bj) { const size_t ro = (size_t)(ai * HALF + m * 16) * DM + bj * HALF;
                        f32x4 g0, g1; fp8x8_to_f32(*(const u32x2*)(sg + ro), g0, g1);
                        *(f32x4*)(sl + ro) = acc[ai][bj][m][0] * (1.0f / (O_SCALE * WO_SCALE * G_SCALE)) * g0;
                        *(f32x4*)(sl + ro + 4) = acc[ai][bj][m][1] * (1.0f / (O_SCALE * WO_SCALE * G_SCALE)) * g1; }
            return;
        }
        const unsigned loff = (unsigned)((wr * 64 + fr) * DM + wc * 32 + 8 * fq);
        const size_t ub = (size_t)(u.pm * 256) * DM + u.pn * 256;
        const char* zb_ = uni_ptr((const char*)zb + ub); char* za_ = uni_ptr((char*)za + ub); char* m8_ = uni_ptr((char*)m8 + ub);
        asm volatile("" : "+s"(zb_), "+s"(za_), "+s"(m8_));
        const GAS char* zbp = (const GAS char*)zb_; GAS char* zap = (GAS char*)za_; GAS char* m8p = (GAS char*)m8_;
        u32x2 sa[4][2], sb[4][2];
#define EM_LOAD(ai_, m_, bj_) do { const unsigned ro_ = (unsigned)(((ai_) * HALF + (m_) * 16) * DM + (bj_) * HALF); \
            sb[m_][bj_] = *(const GAS u32x2*)(zbp + ro_ + loff); if (u.sub == 0) sa[m_][bj_] = *(const GAS u32x2*)(zap + ro_ + loff); } while (0)
#pragma unroll
        for (int m = 0; m < 4; ++m)
#pragma unroll
            for (int bj = 0; bj < 2; ++bj) EM_LOAD(0, m, bj);
#pragma unroll
        for (int ai = 0; ai < 2; ++ai) {
#pragma unroll
            for (int m = 0; m < 4; ++m)
#pragma unroll
                for (int bj = 0; bj < 2; ++bj) { const unsigned ro = (unsigned)((ai * HALF + m * 16) * DM + bj * HALF);
                    f32x4 b0, b1; fp8x8_to_f32(sb[m][bj], b0, b1);
                    if (u.sub == 0) {
                        f32x4 a0, a1; fp8x8_to_f32(sa[m][bj], a0, a1);
#pragma unroll
                        for (int e = 0; e < 4; ++e) { acc[ai][bj][m][0][e] *= a0[e] * __builtin_amdgcn_rcpf(fmaxf(b0[e], 1e-30f)); acc[ai][bj][m][1][e] *= a1[e] * __builtin_amdgcn_rcpf(fmaxf(b1[e], 1e-30f)); } }
                    else {
                        const f32x4 v0 = acc[ai][bj][m][0] * b0 * (M_SCALE / (O_SCALE * WO_SCALE * G_SCALE)), v1 = acc[ai][bj][m][1] * b1 * (M_SCALE / (O_SCALE * WO_SCALE * G_SCALE));
                        u32x2 w8; w8.x = cvt_pk4_fp8(v0[0], v0[1], v0[2], v0[3]); w8.y = cvt_pk4_fp8(v1[0], v1[1], v1[2], v1[3]);
                        *(GAS u32x2*)(m8p + ro + loff) = w8; }
                    if (ai == 0) EM_LOAD(1, m, bj); }
        }
#undef EM_LOAD
    }
};
template <bool SRC_F32> struct EpiResid {
    static constexpr bool PERM = true;
    static __device__ __forceinline__ int mapn(int pn) { return pn; }
    static __device__ __forceinline__ bool keep(const Unit&) { return false; }
    const float* xf; bf16_t* xb; const float* gate; float* slab;
    __device__ __forceinline__ void operator()(const Acc& acc, const Unit& u, int wr, int wc, int fr, int fq) const {
        const int col0 = u.pn * 256 + wc * 32 + 8 * fq;
        if (u.part) {
            const int ks = u.part - 1, rs0 = u.pm * 256 - MP;
            char* sl_ = uni_ptr((char*)(slab + ((size_t)ks * MS + rs0) * DM + u.pn * 256));
            asm volatile("" : "+s"(sl_));
            GAS char* sl = (GAS char*)sl_;
            const unsigned lo4 = (unsigned)((wr * 64 + fr) * DM + wc * 32 + 8 * fq) * 4u;
#pragma unroll
            for (int ai = 0; ai < 2; ++ai)
#pragma unroll
                for (int m = 0; m < 4; ++m) {
                    const int gi = NB_P + ((rs0 + ai * HALF + wr * 64) >> 5) + (m >> 1);
                    const float* grow = gate + (size_t)gi * NADA + col0;
#pragma unroll
                    for (int bj = 0; bj < 2; ++bj)
#pragma unroll
                        for (int n = 0; n < 2; ++n) { const int co = bj * HALF + n * 4;
                            *(GAS f32x4*)(sl + (unsigned)((ai * HALF + m * 16) * DM + co) * 4u + lo4) = *(const f32x4*)(grow + co) * acc[ai][bj][m][n] * (SRC_F32 ? 1.0f / (WOUT_SCALE * M_SCALE) : 1.0f / WDN_SCALE); }
                }
            return;
        }
        const unsigned lofe = (unsigned)((wr * 64 + fr) * DM + wc * 32 + 8 * fq), lo4 = lofe * 4u, lo2 = lofe * 2u;
        const size_t ube = (size_t)(u.pm * 256) * DM + u.pn * 256;
        const char* xs_ = uni_ptr((const char*)xf + ube * 4); char* bs_ = uni_ptr((char*)xb + ube * 2); const float* gs_ = gate + (size_t)(u.pm >> 4) * NADA + col0;
        asm volatile("" : "+s"(xs_), "+s"(bs_));
        const GAS char* xs = (const GAS char*)xs_; GAS char* bs = (GAS char*)bs_;
        f32x4 g[2][2];
#pragma unroll
        for (int bj = 0; bj < 2; ++bj)
#pragma unroll
            for (int n = 0; n < 2; ++n) g[bj][n] = *(const f32x4*)(gs_ + bj * HALF + n * 4) * (SRC_F32 ? 1.0f / (WOUT_SCALE * M_SCALE) : 1.0f / WDN_SCALE);
        f32x4 x[4][2][2]; u32x4 xw[4][2];
#define ER_LOAD(ai_, m_, bj_) do { const size_t eo_ = (size_t)((ai_) * HALF + (m_) * 16) * DM + (bj_) * HALF; \
            if constexpr (SRC_F32) { x[m_][bj_][0] = __builtin_nontemporal_load((const GAS f32x4*)(xs + eo_ * 4 + lo4)); x[m_][bj_][1] = __builtin_nontemporal_load((const GAS f32x4*)(xs + eo_ * 4 + 16 + lo4)); } \
            else xw[m_][bj_] = *(const GAS u32x4*)(bs + eo_ * 2 + lo2); } while (0)
#pragma unroll
        for (int m = 0; m < 4; ++m)
#pragma unroll
            for (int bj = 0; bj < 2; ++bj) ER_LOAD(0, m, bj);
#pragma unroll
        for (int ai = 0; ai < 2; ++ai) {
#pragma unroll
            for (int m = 0; m < 4; ++m)
#pragma unroll
                for (int bj = 0; bj < 2; ++bj) { const size_t eo = (size_t)(ai * HALF + m * 16) * DM + bj * HALF;
                    f32x4 x0, x1;
                    if constexpr (SRC_F32) { x0 = x[m][bj][0]; x1 = x[m][bj][1]; }
                    else { const u32x4 w = xw[m][bj]; x0 = (f32x4){bf_lo(w.x), bf_hi(w.x), bf_lo(w.y), bf_hi(w.y)}; x1 = (f32x4){bf_lo(w.z), bf_hi(w.z), bf_lo(w.w), bf_hi(w.w)}; }
                    x0 += g[bj][0] * acc[ai][bj][m][0]; x1 += g[bj][1] * acc[ai][bj][m][1];
                    u32x4 o; o.x = cvt_pk_bf16(x0[0], x0[1]); o.y = cvt_pk_bf16(x0[2], x0[3]); o.z = cvt_pk_bf16(x1[0], x1[1]); o.w = cvt_pk_bf16(x1[2], x1[3]);
                    *(GAS u32x4*)(bs + eo * 2 + lo2) = o;
                    if (ai == 0) ER_LOAD(1, m, bj); }
        }
#undef ER_LOAD
    }
};
struct EpiSwiglu {
    static constexpr bool PERM = true;
    static __device__ __forceinline__ int mapn(int pn) { return pn; }
    static __device__ __forceinline__ bool keep(const Unit&) { return false; }
    bf16_t* act;
    __device__ __forceinline__ void operator()(const Acc& acc, const Unit& u, int wr, int wc, int fr, int fq) const {
        unsigned char* base = (unsigned char*)act + (size_t)(u.pm * 256 + wr * 64 + fr) * DFF + u.pn * 128 + wc * 32 + 8 * fq;
#pragma unroll
        for (int ai = 0; ai < 2; ++ai)
#pragma unroll
            for (int m = 0; m < 4; ++m) {
                const f32x4 g0 = acc[ai][0][m][0], g1 = acc[ai][0][m][1], u0 = acc[ai][1][m][0], u1 = acc[ai][1][m][1];
                float a[8];
#pragma unroll
                for (int e = 0; e < 4; ++e) { a[e] = g0[e] * sigmoid_f(g0[e]) * u0[e]; a[4 + e] = g1[e] * sigmoid_f(g1[e]) * u1[e]; }
                u32x2 w; w.x = cvt_pk4_fp8(a[0], a[1], a[2], a[3]); w.y = cvt_pk4_fp8(a[4], a[5], a[6], a[7]);
                __builtin_nontemporal_store(w, (u32x2*)(base + (size_t)(ai * HALF + m * 16) * DFF));
            }
    }
};

typedef int v8i32 __attribute__((ext_vector_type(8))); typedef int v4i32 __attribute__((ext_vector_type(4))); typedef float f32x8 __attribute__((ext_vector_type(8)));
__device__ __forceinline__ v8i32 cat8(bf16x8 lo, bf16x8 hi) { return __builtin_shufflevector(__builtin_bit_cast(v4i32, lo), __builtin_bit_cast(v4i32, hi), 0, 1, 2, 3, 4, 5, 6, 7); }
template <class Epi, bool ALIGN_EPI = true, bool FP8 = false>
__device__ __forceinline__ void gemm_phase(LAS unsigned char* lds, const Gemm g, const StaticOrder& S, const Epi& E, const int wid) {
    const int lane = lane_id(), tid = wid * 64 + lane, wr = wid >> 2, wc = wid & 3, fr = lane & 15, fq = lane >> 4;
    const int K = g.K;
    unsigned voffA[2], voffB[2];
#pragma unroll
    for (int i = 0; i < 2; ++i) { int R, C; stage_rc(tid * 16 + i * 8192, R, C); const int Rb = Epi::PERM ? ((R & ~31) + perm32(R & 31)) : R;
        const unsigned rpb = FP8 ? (unsigned)K : 2u * (unsigned)K;
        voffA[i] = (unsigned)R * rpb + (unsigned)C * 2u; voffB[i] = (unsigned)Rb * rpb + (unsigned)C * 2u; }
    const size_t kstep = (size_t)(BK * 2);
    const size_t hstep = (size_t)HALF * K * (FP8 ? 1 : 2);
    const size_t tstep = 2 * hstep;
    const unsigned ldsw = (unsigned)wid * 1024u;
    const int aoff = lds_byte(wr * 64 + fr, fq * 8);
    const int boff = lds_byte(wc * 32 + fr, fq * 8);
    constexpr int KOFF = 1024;
#define PG8_SA(b, h) (((b) * 2 + (h)) * HTB)
#define PG8_SB(b, h) ((4 + (b) * 2 + (h)) * HTB)
#define PG8_STAGE(bufoff, gbase, voff) do { _Pragma("unroll") for (int _i = 0; _i < 2; ++_i) \
        __builtin_amdgcn_global_load_lds((const unsigned*)((const char*)(gbase) + (voff)[_i]), (LAS unsigned*)(lds + (bufoff) + ldsw + _i * 8192), 16, 0, 0); } while (0)
#define PG8_LDA(dst, b, h) do { _Pragma("unroll") for (int m = 0; m < 4; ++m) _Pragma("unroll") for (int k = 0; k < 2; ++k) dst[m][k] = *(const LAS bf16x8*)(lds + PG8_SA(b, h) + aoff + m * 2048 + k * KOFF); } while (0)
#define PG8_LDB(dst, b, h) do { _Pragma("unroll") for (int n = 0; n < 2; ++n) _Pragma("unroll") for (int k = 0; k < 2; ++k) dst[n][k] = *(const LAS bf16x8*)(lds + PG8_SB(b, h) + boff + n * 2048 + k * KOFF); } while (0)
#define PG8_MMA(ai, bj, At, Bt) do { __builtin_amdgcn_s_setprio(1); _Pragma("unroll") for (int m = 0; m < 4; ++m) { \
        if constexpr (FP8) { const f32x8 c_ = acc8[ai][bj][m]; const v8i32 a_ = cat8(At[m][0], At[m][1]); \
            const f32x4 lo_ = __builtin_amdgcn_mfma_scale_f32_16x16x128_f8f6f4(cat8(Bt[0][0], Bt[0][1]), a_, __builtin_shufflevector(c_, c_, 0, 1, 2, 3), 0, 0, 0, 0x7F7F7F7F, 0, 0x7F7F7F7F); \
            const f32x4 hi_ = __builtin_amdgcn_mfma_scale_f32_16x16x128_f8f6f4(cat8(Bt[1][0], Bt[1][1]), a_, __builtin_shufflevector(c_, c_, 4, 5, 6, 7), 0, 0, 0, 0x7F7F7F7F, 0, 0x7F7F7F7F); \
            acc8[ai][bj][m] = __builtin_shufflevector(lo_, hi_, 0, 1, 2, 3, 4, 5, 6, 7); } \
        else { _Pragma("unroll") for (int n = 0; n < 2; ++n) _Pragma("unroll") for (int k = 0; k < 2; ++k) acc[ai][bj][m][n] = __builtin_amdgcn_mfma_f32_16x16x32_bf16(Bt[n][k], At[m][k], acc[ai][bj][m][n], 0, 0, 0); } } \
        __builtin_amdgcn_s_setprio(0); } while (0)
#define PG8_WAIT_V(n) asm volatile("s_waitcnt vmcnt(" #n ")" ::: "memory")
#define PG8_WAIT_L(n) asm volatile("s_waitcnt lgkmcnt(" #n ")" ::: "memory")
#define PG8_BAR __builtin_amdgcn_s_barrier()
#define PG8_SCHED __builtin_amdgcn_sched_barrier(0)
#define PG8_UA(u) ((const char*)((u).sub ? g.A2 : g.A) + (size_t)(u).pm * tstep + (size_t)(u).kt0 * kstep)
#define PG8_UB(u) ((const char*)((u).sub ? g.Bt2 : g.Bt) + (size_t)(u).pn * tstep + (size_t)(u).kt0 * kstep)
    Unit cur, nxt; int ui = 0;
    if (!S.next(0, cur)) return;
    cur.pn = Epi::mapn(cur.pn);
    Acc acc;
#pragma unroll
    for (int a = 0; a < 2; ++a)
#pragma unroll
        for (int b = 0; b < 2; ++b)
#pragma unroll
            for (int m = 0; m < 4; ++m)
#pragma unroll
                for (int n = 0; n < 2; ++n) acc[a][b][m][n] = (f32x4){0.f, 0.f, 0.f, 0.f};
    f32x8 acc8[2][2][4];
#pragma unroll
    for (int a = 0; a < 2; ++a)
#pragma unroll
        for (int b = 0; b < 2; ++b)
#pragma unroll
            for (int m = 0; m < 4; ++m) acc8[a][b][m] = (f32x8){0.f, 0.f, 0.f, 0.f, 0.f, 0.f, 0.f, 0.f};
    bf16x8 At[4][2], B0[2][2], B1[2][2];
    const char* cA = PG8_UA(cur); const char* cB = PG8_UB(cur);
    PG8_STAGE(PG8_SB(0, 0), cB, voffB); PG8_STAGE(PG8_SB(0, 1), cB + hstep, voffB); PG8_STAGE(PG8_SA(0, 0), cA, voffA); PG8_STAGE(PG8_SA(0, 1), cA + hstep, voffA);
    if (wr == 1) PG8_BAR;
    PG8_WAIT_V(2); PG8_BAR;
    PG8_STAGE(PG8_SB(1, 0), cB + kstep, voffB); PG8_STAGE(PG8_SA(1, 0), cA + kstep, voffA); PG8_STAGE(PG8_SB(1, 1), cB + hstep + kstep, voffB);
    PG8_WAIT_V(6); PG8_BAR;
    for (;;) {
        const bool has_next = S.next(ui + 1, nxt);
        nxt.pn = Epi::mapn(nxt.pn);
        const char* nA = has_next ? PG8_UA(nxt) : cA; const char* nB = has_next ? PG8_UB(nxt) : cB;
        const int nt = cur.nkt;
        for (int t = 0; t < nt; t += 2) {
            const bool last = (t == nt - 2);
            if constexpr (FP8) {
#pragma unroll
                for (int a = 0; a < 2; ++a)
#pragma unroll
                    for (int b = 0; b < 2; ++b)
#pragma unroll
                        for (int m = 0; m < 4; ++m) asm volatile("" : "+v"(acc8[a][b][m]));
            }
            const char* a1 = cA + (size_t)(t + 1) * kstep;
            const char* a2 = last ? nA : cA + (size_t)(t + 2) * kstep; const char* b2 = last ? nB : cB + (size_t)(t + 2) * kstep;
            const char* a3 = a2 + kstep; const char* b3 = b2 + kstep;
            PG8_LDB(B0, 0, 0); PG8_LDB(B1, 0, 1); PG8_SCHED; PG8_LDA(At, 0, 0); PG8_STAGE(PG8_SA(1, 1), a1 + hstep, voffA);
            PG8_WAIT_V(8); PG8_WAIT_L(0); PG8_BAR; PG8_MMA(0, 0, At, B0); PG8_MMA(0, 1, At, B1); PG8_BAR; PG8_SCHED;
            PG8_LDA(At, 0, 1); PG8_STAGE(PG8_SB(0, 0), b2, voffB); PG8_STAGE(PG8_SB(0, 1), b2 + hstep, voffB); PG8_STAGE(PG8_SA(0, 0), a2, voffA);
            PG8_WAIT_V(8); PG8_WAIT_L(0); PG8_BAR; PG8_MMA(1, 0, At, B0); PG8_MMA(1, 1, At, B1); PG8_BAR; PG8_SCHED;
            PG8_LDB(B0, 1, 0); PG8_LDB(B1, 1, 1); PG8_SCHED; PG8_LDA(At, 1, 0); PG8_STAGE(PG8_SA(0, 1), a2 + hstep, voffA);
            PG8_WAIT_V(8); PG8_WAIT_L(0); PG8_BAR; PG8_MMA(0, 0, At, B0); PG8_MMA(0, 1, At, B1); PG8_BAR; PG8_SCHED;
            PG8_LDA(At, 1, 1); PG8_STAGE(PG8_SB(1, 0), b3, voffB); PG8_STAGE(PG8_SB(1, 1), b3 + hstep, voffB); PG8_STAGE(PG8_SA(1, 0), a3, voffA);
            PG8_WAIT_V(8); PG8_WAIT_L(0); PG8_BAR; PG8_MMA(1, 0, At, B0); PG8_MMA(1, 1, At, B1); PG8_BAR; PG8_SCHED;
        }
        if constexpr (ALIGN_EPI) { if (wr == 0) PG8_BAR; }
        if constexpr (FP8) {
#pragma unroll
            for (int a = 0; a < 2; ++a)
#pragma unroll
                for (int b = 0; b < 2; ++b)
#pragma unroll
                    for (int m = 0; m < 4; ++m) { const f32x8 c_ = acc8[a][b][m]; acc[a][b][m][0] = __builtin_shufflevector(c_, c_, 0, 1, 2, 3); acc[a][b][m][1] = __builtin_shufflevector(c_, c_, 4, 5, 6, 7); }
        }
        const bool keep = Epi::keep(cur);
        E(acc, cur, wr, wc, fr, fq);
        if (!has_next) break;
#pragma unroll
        for (int a = 0; a < 2; ++a)
#pragma unroll
            for (int b = 0; b < 2; ++b)
#pragma unroll
                for (int m = 0; m < 4; ++m) {
                    if (!keep) { acc[a][b][m][0] = (f32x4){0.f, 0.f, 0.f, 0.f}; acc[a][b][m][1] = (f32x4){0.f, 0.f, 0.f, 0.f}; }
                    if constexpr (FP8) acc8[a][b][m] = __builtin_shufflevector(acc[a][b][m][0], acc[a][b][m][1], 0, 1, 2, 3, 4, 5, 6, 7); }
        cur = nxt; cA = nA; cB = nB; ++ui;
        if constexpr (ALIGN_EPI) { if (wr == 1) PG8_BAR; }
    }
    PG8_WAIT_V(0);
    if constexpr (!ALIGN_EPI) { if (wr == 0) PG8_BAR; }
    PG8_BAR;
#undef PG8_SA
#undef PG8_SB
#undef PG8_STAGE
#undef PG8_LDA
#undef PG8_LDB
#undef PG8_MMA
#undef PG8_WAIT_V
#undef PG8_WAIT_L
#undef PG8_BAR
#undef PG8_SCHED
#undef PG8_UA
#undef PG8_UB
}
}

namespace att {
constexpr int D = 128, LDR = 1024;
constexpr float SCALE = 0.08838834764831845f, INV_SCALE = 11.313708498984761f, THR = 8.f;
constexpr int NW = 8, QBLK = 32, KVBLK = 64, QB = NW * QBLK;
constexpr int SHM_V = KVBLK * D * 2, SHM_K = KVBLK * D * 2;
constexpr int OFF_WS = 2 * SHM_V + 2 * SHM_K, OFF_FL = OFF_WS + NW * 64 * 4  , OFF_TB = OFF_FL + FNEG_LD * 4  , OFF_QW = OFF_TB + 1040, LDS_USED = OFF_QW + 16;
enum { FOXP = 0, BANDP = 1, FOXS = 2, BANDS = 3 };
#define KSWZ(row, colB) ((row) * 256 + ((colB) ^ (((row) & 7) << 4)))
#define SBAR() __builtin_amdgcn_sched_barrier(0)
__device__ __forceinline__ int v_st(int k, int c) { const int kk = (k & ~0xC) | ((k & 4) << 1) | ((k & 8) >> 1); return ((kk >> 3) * 4 + (c >> 5)) * 512 + ((kk & 7) * 32 + (c & 31)) * 2; }
__device__ __forceinline__ int v_rd_base(int lane) { return ((lane & 3) << 3) | (((lane >> 2) & 3) << 6) | (((lane >> 4) & 1) << 5) | (((lane >> 5) & 1) << 8); }
constexpr int v_rd_off(int d0, int ks, int half) { return d0 * 512 + ks * 4096 + half * 2048; }
__device__ __forceinline__ int crow(int r, int hi) { return (r & 3) + 8 * (r >> 2) + 4 * hi; }
__device__ __forceinline__ unsigned cvtpk(float lo, float hi) { unsigned r; asm volatile("v_cvt_pk_bf16_f32 %0, %1, %2" : "=v"(r) : "v"(lo), "v"(hi)); return r; }
__device__ __forceinline__ unsigned o_quad_fp8(float v) {
    const float s = v * O_SCALE;
    const float sn = __shfl_xor(s, 1);
    const int pk = __builtin_amdgcn_cvt_pk_fp8_f32(s, sn, 0, false);
    const int pk2 = __builtin_amdgcn_update_dpp(pk, pk, 0x4E, 0xF, 0xF, false);
    return ((unsigned)pk & 0xFFFFu) | ((unsigned)pk2 << 16);
}
__device__ __forceinline__ bf16x8 pack8(f32x4 a, f32x4 b) { u32x4 w = {cvtpk(a[0], a[1]), cvtpk(a[2], a[3]), cvtpk(b[0], b[1]), cvtpk(b[2], b[3])}; return *reinterpret_cast<bf16x8*>(&w); }
__device__ __forceinline__ void mask_tile(f32x16& p0, f32x16& p1, int dq, unsigned W) {
    const float NEG = -__builtin_inff();
#pragma unroll
    for (int r = 0; r < 16; ++r) { const int c = (r & 3) + 8 * (r >> 2);
        if ((unsigned)(dq - c) >= W) p0[r] = NEG;
        if ((unsigned)(dq - c - 32) >= W) p1[r] = NEG; }
}
__device__ __forceinline__ void band_bias(f32x16& p0, f32x16& p1, int dq, const LAS float* tb) {
#pragma unroll
    for (int r = 0; r < 16; ++r) { const int c = (r & 3) + 8 * (r >> 2);
        int i0 = dq - c + 128; i0 = i0 < 0 ? 0 : (i0 > 256 ? 256 : i0);
        int i1 = dq - c - 32 + 128; i1 = i1 < 0 ? 0 : (i1 > 256 ? 256 : i1);
        p0[r] += tb[i0]; p1[r] += tb[i1]; }
}
__device__ __forceinline__ void partialSM(f32x16& p0, f32x16& p1, float& m_reg, float& mn, float& alpha) {
    float pmax = p0[0];
#pragma unroll
    for (int r = 1; r < 16; ++r) pmax = fmaxf(pmax, p0[r]);
#pragma unroll
    for (int r = 0; r < 16; ++r) pmax = fmaxf(pmax, p1[r]);
    { auto rr = __builtin_amdgcn_permlane32_swap(__float_as_uint(pmax), __float_as_uint(pmax), false, false);
      pmax = fmaxf(__uint_as_float(rr[0]), __uint_as_float(rr[1])); }
    constexpr float C2 = 1.4426950408889634f * SCALE;
    if (__builtin_expect(__all((pmax - m_reg) * SCALE <= THR), 1)) { mn = m_reg; alpha = 1.f; }
    else { mn = fmaxf(m_reg, pmax); alpha = __builtin_amdgcn_exp2f((m_reg - mn) * C2); m_reg = mn; }
    const float mnL = -mn * C2;
#pragma unroll
    for (int r = 0; r < 16; ++r) p0[r] = fmaf(p0[r], C2, mnL);
#pragma unroll
    for (int r = 0; r < 16; ++r) p1[r] = fmaf(p1[r], C2, mnL);
#pragma unroll
    for (int r = 0; r < 16; ++r) p0[r] = __builtin_amdgcn_exp2f(p0[r]);
}
__device__ __forceinline__ void finishSM(f32x16& p0, f32x16& p1, float alpha, float& l_reg, bf16x8& pa0, bf16x8& pa1, bf16x8& pa2, bf16x8& pa3) {
#pragma unroll
    for (int r = 0; r < 16; ++r) p1[r] = __builtin_amdgcn_exp2f(p1[r]);
    float ps = 0;
#pragma unroll
    for (int r = 0; r < 16; ++r) ps += p0[r];
#pragma unroll
    for (int r = 0; r < 16; ++r) ps += p1[r];
    { auto rr = __builtin_amdgcn_permlane32_swap(__float_as_uint(ps), __float_as_uint(ps), false, false);
      ps = __uint_as_float(rr[0]) + __uint_as_float(rr[1]); }
    l_reg = l_reg * alpha + ps;
#define PK4(P, B_, OUT) do { unsigned a0 = cvtpk(P[B_+0], P[B_+1]), a1 = cvtpk(P[B_+2], P[B_+3]);                          \
        unsigned b0 = cvtpk(P[B_+4], P[B_+5]), b1 = cvtpk(P[B_+6], P[B_+7]);                                             \
        auto r0 = __builtin_amdgcn_permlane32_swap(a0, b0, false, false); auto r1 = __builtin_amdgcn_permlane32_swap(a1, b1, false, false); \
        u32x4 w = {r0[0], r1[0], r0[1], r1[1]}; OUT = *reinterpret_cast<bf16x8*>(&w); } while (0)
    PK4(p0, 0, pa0); PK4(p0, 8, pa1); PK4(p1, 0, pa2); PK4(p1, 8, pa3);
#undef PK4
}
template <int KB, bool SK, bool FOX>
__device__ __forceinline__ void qkt(f32x16& p0, f32x16& p1, const char* K_lds, int r32, int hi, const bf16x8* qr, bool act, const LAS float* fb) {
    if (SK && !act) { const float NEG = -__builtin_inff();
#pragma unroll
        for (int r = 0; r < 16; ++r) { p0[r] = NEG; p1[r] = NEG; } return; }
    if constexpr (FOX) {
#pragma unroll
        for (int g = 0; g < 4; ++g) { const f32x4 a = *(const LAS f32x4*)(fb + 8 * g), b = *(const LAS f32x4*)(fb + 32 + 8 * g);
            p0[4 * g] = a[0]; p0[4 * g + 1] = a[1]; p0[4 * g + 2] = a[2]; p0[4 * g + 3] = a[3];
            p1[4 * g] = b[0]; p1[4 * g + 1] = b[1]; p1[4 * g + 2] = b[2]; p1[4 * g + 3] = b[3]; }
    } else { p0 = f32x16{}; p1 = f32x16{}; }
    const char* kb[4];
#pragma unroll
    for (int dd = 0; dd < 4; ++dd) kb[dd] = K_lds + KB * SHM_K + KSWZ(r32, (dd * 16 + hi * 8) * 2);
#pragma unroll
    for (int d0 = 0; d0 < 8; ++d0) { const char* a = kb[d0 & 3] + (d0 >> 2) * 128;
        bf16x8 b0 = *reinterpret_cast<const bf16x8*>(a);
        bf16x8 b1 = *reinterpret_cast<const bf16x8*>(a + 32 * 256);
        p0 = __builtin_amdgcn_mfma_f32_32x32x16_bf16(b0, qr[d0], p0, 0, 0, 0);
        p1 = __builtin_amdgcn_mfma_f32_32x32x16_bf16(b1, qr[d0], p1, 0, 0, 0); }
}
template <int VB, bool SK>
__device__ __forceinline__ void pv_tile(f32x16* o, int vb0, bf16x8 pa0, bf16x8 pa1, bf16x8 pa2, bf16x8 pa3, bool act) {
    if (SK && !act) return;
#define TRRD(dst, off) asm volatile("ds_read_b64_tr_b16 %0, %1 offset:%2" : "=&v"(dst) : "v"(vb0), "i"(off) : "memory")
#define PV_D0(d0) do { s16x4 l0, l1, l2, l3, h0, h1, h2, h3; constexpr int b_ = VB * SHM_V + v_rd_off(d0, 0, 0); \
        TRRD(l0, b_); TRRD(h0, b_ + 2048); TRRD(l1, b_ + 4096); TRRD(h1, b_ + 6144); TRRD(l2, b_ + 8192); TRRD(h2, b_ + 10240); TRRD(l3, b_ + 12288); TRRD(h3, b_ + 14336); \
        asm volatile("s_waitcnt lgkmcnt(0)" ::: "memory"); SBAR();   \
        o[d0] = __builtin_amdgcn_mfma_f32_32x32x16_bf16(pa0, (bf16x8){l0[0], l0[1], l0[2], l0[3], h0[0], h0[1], h0[2], h0[3]}, o[d0], 0, 0, 0);   \
        o[d0] = __builtin_amdgcn_mfma_f32_32x32x16_bf16(pa1, (bf16x8){l1[0], l1[1], l1[2], l1[3], h1[0], h1[1], h1[2], h1[3]}, o[d0], 0, 0, 0);   \
        o[d0] = __builtin_amdgcn_mfma_f32_32x32x16_bf16(pa2, (bf16x8){l2[0], l2[1], l2[2], l2[3], h2[0], h2[1], h2[2], h2[3]}, o[d0], 0, 0, 0);   \
        o[d0] = __builtin_amdgcn_mfma_f32_32x32x16_bf16(pa3, (bf16x8){l3[0], l3[1], l3[2], l3[3], h3[0], h3[1], h3[2], h3[3]}, o[d0], 0, 0, 0); } while (0)
    PV_D0(0); PV_D0(1); PV_D0(2); PV_D0(3);
#undef PV_D0
#undef TRRD
}

struct Job { const bf16* Q; bf16* O; const void* K; const void* V; const float* Kn; const float* Vn; int P0, j_lo, j_hi; };
struct Seam { bf16x8 qr[8]; bf16x8 st_v0, st_v1, st_k0, st_k1; f32x4 sf0, sf1, sf2, sf3; };
template <int MODE> struct Cfg {
    static constexpr bool F32 = MODE >= FOXS, SHQ = MODE >= FOXS, FOX = (MODE == FOXP || MODE == FOXS), BAND = !FOX, SK = (MODE == BANDP);
    static constexpr int NC = MODE == FOXS ? PAST : (MODE == BANDS ? LBAND : (1 << 30));
    static constexpr int NVALID = LBAND + TS;
};
#define VMW() asm volatile("s_waitcnt vmcnt(0)" ::: "memory")
#define VMWN(n) asm volatile("s_waitcnt vmcnt(%0)" :: "i"(n) : "memory")
#define SLOAD_H(Kp, Vp, k0) do { const char* kt_ = (const char*)(Kp) + (size_t)(k0) * (LDR * 2); const char* vt_ = (const char*)(Vp) + (size_t)(k0) * (LDR * 2); \
                                 S.st_v0 = *(const bf16x8*)(vt_ + kvo2); S.st_v1 = *(const bf16x8*)(vt_ + 32 * LDR * 2 + kvo2);              \
                                 S.st_k0 = *(const bf16x8*)(kt_ + kvo2); S.st_k1 = *(const bf16x8*)(kt_ + 32 * LDR * 2 + kvo2); } while (0)
#define SWRITE_HK(bf) do { *(bf16x8*)(K_lds + (bf) * SHM_K + kws) = S.st_k0; *(bf16x8*)(K_lds + (bf) * SHM_K + kws + 32 * 256) = S.st_k1; } while (0)
#define SWRITE_HV(bf) do { *(bf16x8*)(V_lds + (bf) * SHM_V + vst0) = S.st_v0; *(bf16x8*)(V_lds + (bf) * SHM_V + vst1) = S.st_v1; } while (0)
#define SWRITE_H(bf) do { SWRITE_HV(bf); SWRITE_HK(bf); } while (0)
#define SLOAD_F(pc, pnw, k0) do { const bool nw_ = (k0) >= C::NC; const char* b_ = nw_ ? (const char*)(pnw) : (const char*)(pc) + (size_t)(k0) * (LDR * 4); \
        const char* b1_ = b_ + (nw_ ? 0 : 32 * LDR * 4);                                                                                    \
        S.sf0 = *(const f32x4*)(b_ + kvo4); S.sf1 = *(const f32x4*)(b_ + 16 + kvo4); S.sf2 = *(const f32x4*)(b1_ + kvo4); S.sf3 = *(const f32x4*)(b1_ + 16 + kvo4); } while (0)
#define SWRITE_KF(bf) do { *(bf16x8*)(K_lds + (bf) * SHM_K + kws) = pack8(S.sf0, S.sf1); *(bf16x8*)(K_lds + (bf) * SHM_K + kws + 32 * 256) = pack8(S.sf2, S.sf3); } while (0)
#define SWRITE_VF(bf) do { *(bf16x8*)(V_lds + (bf) * SHM_V + vst0) = pack8(S.sf0, S.sf1); *(bf16x8*)(V_lds + (bf) * SHM_V + vst1) = pack8(S.sf2, S.sf3); } while (0)

template <int MODE>
__device__ __forceinline__ void attn_prime(const Job& cur, char* lds, Seam& S, const int wid) {
    using C = Cfg<MODE>;
    const int lane = lane_id(), tid = wid * 64 + lane, r32 = lane & 31, hi = lane >> 5;
    const int sr = tid >> 4, sc = (tid & 15) * 8, kws = KSWZ(sr, sc * 2); char* K_lds = lds + 2 * SHM_V;
    const unsigned kvo2 = (unsigned)(sr * LDR + sc) * 2u, kvo4 = (unsigned)(sr * LDR + sc) * 4u; (void)kvo2; (void)kvo4;
    const int kb0 = cur.j_lo * KVBLK;
    { const char* Qu = (const char*)cur.Q + (size_t)(C::SHQ ? 0 : wid * QBLK) * (LDR * 2); const unsigned qo = (unsigned)(r32 * LDR + hi * 8) * 2u;
#pragma unroll
      for (int d0 = 0; d0 < 8; ++d0) S.qr[d0] = *(const bf16x8*)(Qu + d0 * 32 + qo); }
    if constexpr (C::F32) { SLOAD_F(cur.K, cur.Kn, kb0); VMW(); SWRITE_KF(0); SBAR(); SLOAD_F(cur.V, cur.Vn, kb0); }
    else { SLOAD_H(cur.K, cur.V, kb0); VMW(); SWRITE_HK(0); }
    __syncthreads();
}
template <int MODE>
__device__ __forceinline__ void attn_block(const Job& cur, const Job& nxt, char* lds, Seam& S, const int wid) {
    using C = Cfg<MODE>;
    constexpr bool F32 = C::F32, SK = C::SK;
    const int lane = lane_id(), tid = wid * 64 + lane, r32 = lane & 31, hi = lane >> 5;
    const int j_lo = cur.j_lo, NT = cur.j_hi - cur.j_lo;
    const int kbn = nxt.j_lo * KVBLK;
    const int qlo = cur.P0 + (C::SHQ ? 0 : wid * QBLK), qm = qlo + r32 - 4 * hi;
    const int cw = (cur.P0 >> 6) + (wid >> 1);
    char* V_lds = lds; char* K_lds = lds + 2 * SHM_V;
    float* ws = (float*)(lds + OFF_WS) + wid * 64; float* li_l = ws, * al_l = ws + 32;
    const LAS float* FLh = (const LAS float*)(LAS char*)(lds + OFF_FL) + 4 * hi;
    const LAS float* TB = (const LAS float*)(LAS char*)(lds + OFF_TB);
    float m_reg = -1e30f, l_reg = 0; f32x16 o[4] = {};
    const int sr = tid >> 4, sc = (tid & 15) * 8, vst0 = v_st(sr, sc), vst1 = v_st(32 + sr, sc), kws = KSWZ(sr, sc * 2);
    const unsigned kvo2 = (unsigned)(sr * LDR + sc) * 2u, kvo4 = (unsigned)(sr * LDR + sc) * 4u; (void)kvo2; (void)kvo4;
    const int vb0 = (int)(uintptr_t)V_lds + v_rd_base(lane);
#define RESC(a) do { if (__any((a) < 1.f)) { if (hi == 0) al_l[r32] = (a); asm volatile("s_waitcnt lgkmcnt(0)" ::: "memory");              \
                     _Pragma("unroll") for (int d_ = 0; d_ < 4; ++d_) _Pragma("unroll") for (int r = 0; r < 16; ++r) o[d_][r] *= al_l[crow(r, hi)]; } } while (0)
#define KBASE(t) ((j_lo + (t)) * KVBLK)
#define ACT(t) (!SK || ((j_lo + (t)) >= cw - 8 && (j_lo + (t)) <= cw))
#define MASKT(P0_, P1_, t) do { const int kb_ = KBASE(t);                                                                                   \
        if constexpr (C::BAND) { if (ACT(t) && kb_ + KVBLK - 1 > qlo - 128) band_bias(P0_, P1_, qm - kb_, TB); }                            \
        if constexpr (C::FOX) { if (kb_ + KVBLK - 1 > qlo) mask_tile(P0_, P1_, qm - kb_, 0x40000000u); }                                    \
        if constexpr (MODE == BANDS) { if (kb_ + KVBLK - 1 >= C::NVALID) mask_tile(P0_, P1_, (C::NVALID - 1 - 4 * hi) - kb_, 0x40000000u); } } while (0)
#define FB(t) (FLh + KBASE(t))
    constexpr int NQL = 8;
#define SEAM_K0() do { VMWN(NQL); if constexpr (F32) { SWRITE_KF(0); SBAR(); SLOAD_F(nxt.V, nxt.Vn, kbn); } else { SWRITE_HK(0); } SBAR(); } while (0)
    f32x16 pA0, pA1, pB0, pB1; float mnA, mnB, alA, alB; bf16x8 pa0, pa1, pa2, pa3;
    if constexpr (F32) { VMW(); SWRITE_VF(0); SBAR(); } else { SWRITE_HV(0); SBAR(); }
    if (NT > 1) { if constexpr (F32) SLOAD_F(cur.K, cur.Kn, KBASE(1)); else SLOAD_H(cur.K, cur.V, KBASE(1)); }
    SBAR(); qkt<0, SK, C::FOX>(pA0, pA1, K_lds, r32, hi, S.qr, ACT(0), FB(0));
    if constexpr (F32) { if (NT > 1) { VMW(); SWRITE_KF(1); SBAR(); SLOAD_F(cur.V, cur.Vn, KBASE(1)); } }
    MASKT(pA0, pA1, 0); partialSM(pA0, pA1, m_reg, mnA, alA);
    if (NT > 1) { VMW(); if constexpr (F32) { SWRITE_VF(1); SBAR(); if (NT > 2) SLOAD_F(cur.K, cur.Kn, KBASE(2)); } else SWRITE_H(1); }
    __syncthreads();
#define HALF_STEP(PX0, PX1, mnX, alX, PY0, PY1, alY, t, KB, VB, SB) do {                                                      \
        SBAR(); qkt<KB, SK, C::FOX>(PX0, PX1, K_lds, r32, hi, S.qr, ACT(t), FB(t));                                           \
        finishSM(PY0, PY1, alY, l_reg, pa0, pa1, pa2, pa3); SBAR();                                                           \
        if ((t) + 1 < NT) { if constexpr (F32) { VMW(); SWRITE_KF(SB); SBAR(); SLOAD_F(cur.V, cur.Vn, KBASE((t) + 1)); }      \
                            else { SLOAD_H(cur.K, cur.V, KBASE((t) + 1)); } SBAR(); }                                         \
        pv_tile<VB, SK>(o, vb0, pa0, pa1, pa2, pa3, ACT((t) - 1)); MASKT(PX0, PX1, (t)); partialSM(PX0, PX1, m_reg, mnX, alX); \
        __syncthreads();                                                                                                      \
        if ((t) + 1 < NT) { VMW(); if constexpr (F32) { SWRITE_VF(SB); SBAR(); if ((t) + 2 < NT) SLOAD_F(cur.K, cur.Kn, KBASE((t) + 2)); } \
                            else { SWRITE_H(SB); } }                                                                          \
        RESC(alX); __syncthreads(); } while (0)
    for (int t = 1; t + 1 < NT; t += 2) {
        HALF_STEP(pB0, pB1, mnB, alB, pA0, pA1, alA, t, 1, 0, 0);
        HALF_STEP(pA0, pA1, mnA, alA, pB0, pB1, alB, t + 1, 0, 1, 1);
    }
    const bool even = (NT & 1) == 0;
    if (even) { SBAR(); qkt<1, SK, C::FOX>(pB0, pB1, K_lds, r32, hi, S.qr, ACT(NT - 1), FB(NT - 1)); SBAR(); }
    if constexpr (F32) { SLOAD_F(nxt.K, nxt.Kn, kbn); SBAR(); }
    else { SLOAD_H(nxt.K, nxt.V, kbn); SBAR(); }
    { const char* Qu = (const char*)nxt.Q + (size_t)(C::SHQ ? 0 : wid * QBLK) * (LDR * 2); const unsigned qo = (unsigned)(r32 * LDR + hi * 8) * 2u;
#pragma unroll
      for (int d0 = 0; d0 < 8; ++d0) S.qr[d0] = *(const bf16x8*)(Qu + d0 * 32 + qo); }
    SBAR();
    finishSM(pA0, pA1, alA, l_reg, pa0, pa1, pa2, pa3); SBAR();
    pv_tile<0, SK>(o, vb0, pa0, pa1, pa2, pa3, ACT(even ? NT - 2 : NT - 1));
    if (even) { MASKT(pB0, pB1, NT - 1); partialSM(pB0, pB1, m_reg, mnB, alB); __syncthreads(); RESC(alB);
        finishSM(pB0, pB1, alB, l_reg, pa0, pa1, pa2, pa3); SBAR(); pv_tile<1, SK>(o, vb0, pa0, pa1, pa2, pa3, ACT(NT - 1)); }
    SBAR(); SEAM_K0();
    if (hi == 0) li_l[r32] = l_reg; asm volatile("s_waitcnt lgkmcnt(0)" ::: "memory");
    float rli[16];
#pragma unroll
    for (int r = 0; r < 16; ++r) rli[r] = __builtin_amdgcn_rcpf(li_l[crow(r, hi)]);
    char* Ou = (char*)cur.O + (size_t)(C::SHQ ? 0 : wid * QBLK) * LDR; const unsigned oo = (unsigned)(4 * hi * LDR + r32);
    if (!C::SHQ || wid == 0) {
#pragma unroll
        for (int r = 0; r < 16; ++r) { const int orc = (r & 3) + 8 * (r >> 2);
#pragma unroll
            for (int d0 = 0; d0 < 4; ++d0) { const unsigned w8 = o_quad_fp8(o[d0][r] * rli[r]);
                if ((r32 & 3) == 0) *(unsigned*)(Ou + (size_t)(orc * LDR + d0 * 32) + oo) = w8; } }
    }
    __syncthreads();
#undef RESC
#undef KBASE
#undef ACT
#undef MASKT
#undef FB
#undef SEAM_K0
#undef HALF_STEP
}
__device__ __forceinline__ void foxs_unit(const bf16* Q, bf16* O, const float* Kc, const float* Vc, const float* Kn, const float* Vn, const float* fn, char* lds, const int wid) {
    const int lane = lane_id(), r32 = lane & 31, hi = lane >> 5;
    char* Kw = lds + wid * 16384; char* Vw = Kw + 8192;
    float* wsf = (float*)(lds + 131072 + 1024) + wid * 64;
    float* ml = (float*)(lds + 131072 + 4096);
    constexpr float C2 = 1.4426950408889634f * SCALE;
    bf16x8 qr[8];
    { const char* Qu = (const char*)Q; const unsigned qo = (unsigned)(r32 * LDR + hi * 8) * 2u;
#pragma unroll
      for (int d0 = 0; d0 < 8; ++d0) qr[d0] = *(const bf16x8*)(Qu + d0 * 32 + qo); }
    float m_reg = -1e30f, l_reg = 0.f; f32x16 o[4] = {};
    const int srow = lane >> 4, scol = (lane & 15) * 8;
    const unsigned so4 = (unsigned)(srow * LDR + scol) * 4u;
    const int vb0 = (int)(uintptr_t)Vw + v_rd_base(lane);
    for (int c = wid; c < 129; c += 8) {
        const int kb = c * 32; const bool nw = (c == 128);
        const char* kbase = nw ? (const char*)Kn : (const char*)Kc + (size_t)kb * (LDR * 4);
        const char* vbase = nw ? (const char*)Vn : (const char*)Vc + (size_t)kb * (LDR * 4);
        f32x4 st[16];
#pragma unroll
        for (int i = 0; i < 8; ++i) { const char* rp = kbase + (size_t)(4 * i) * (LDR * 4) + so4; st[2 * i] = *(const f32x4*)rp; st[2 * i + 1] = *(const f32x4*)(rp + 16); }
        f32x16 p0;
        { const float* fb = fn + kb + 4 * hi;
#pragma unroll
          for (int g = 0; g < 4; ++g) { const f32x4 a = *(const f32x4*)(fb + 8 * g); p0[4 * g] = a[0]; p0[4 * g + 1] = a[1]; p0[4 * g + 2] = a[2]; p0[4 * g + 3] = a[3]; } }
#pragma unroll
        for (int i = 0; i < 8; ++i) { const int row = 4 * i + srow; *(bf16x8*)(Kw + KSWZ(row, scol * 2)) = pack8(st[2 * i], st[2 * i + 1]); }
        SBAR();
#pragma unroll
        for (int i = 0; i < 8; ++i) { const char* rp = vbase + (size_t)(4 * i) * (LDR * 4) + so4; st[2 * i] = *(const f32x4*)rp; st[2 * i + 1] = *(const f32x4*)(rp + 16); }
        asm volatile("s_waitcnt lgkmcnt(0)" ::: "memory"); SBAR();
#pragma unroll
        for (int d0 = 0; d0 < 8; ++d0) { const bf16x8 b0 = *reinterpret_cast<const bf16x8*>(Kw + KSWZ(r32, (d0 * 16 + hi * 8) * 2));
            p0 = __builtin_amdgcn_mfma_f32_32x32x16_bf16(b0, qr[d0], p0, 0, 0, 0); }
        if (nw) { const float NEG = -__builtin_inff();
#pragma unroll
            for (int r = 0; r < 16; ++r) if (crow(r, hi) > r32) p0[r] = NEG; }
        float pmax = p0[0];
#pragma unroll
        for (int r = 1; r < 16; ++r) pmax = fmaxf(pmax, p0[r]);
        { auto rr = __builtin_amdgcn_permlane32_swap(__float_as_uint(pmax), __float_as_uint(pmax), false, false);
          pmax = fmaxf(__uint_as_float(rr[0]), __uint_as_float(rr[1])); }
        float mn, alpha;
        if (__all((pmax - m_reg) * SCALE <= THR)) { mn = m_reg; alpha = 1.f; }
        else { mn = fmaxf(m_reg, pmax); alpha = __builtin_amdgcn_exp2f((m_reg - mn) * C2); m_reg = mn; }
        const float mnL = -mn * C2; float ps = 0.f;
#pragma unroll
        for (int r = 0; r < 16; ++r) { p0[r] = __builtin_amdgcn_exp2f(fmaf(p0[r], C2, mnL)); ps += p0[r]; }
        { auto rr = __builtin_amdgcn_permlane32_swap(__float_as_uint(ps), __float_as_uint(ps), false, false);
          ps = __uint_as_float(rr[0]) + __uint_as_float(rr[1]); }
        l_reg = l_reg * alpha + ps;
        bf16x8 pa0, pa1;
#define PK4(P, B_, OUT) do { unsigned a0 = cvtpk(P[B_+0], P[B_+1]), a1 = cvtpk(P[B_+2], P[B_+3]);                          \
        unsigned b0_ = cvtpk(P[B_+4], P[B_+5]), b1_ = cvtpk(P[B_+6], P[B_+7]);                                           \
        auto r0 = __builtin_amdgcn_permlane32_swap(a0, b0_, false, false); auto r1 = __builtin_amdgcn_permlane32_swap(a1, b1_, false, false); \
        u32x4 w = {r0[0], r1[0], r0[1], r1[1]}; OUT = *reinterpret_cast<bf16x8*>(&w); } while (0)
        PK4(p0, 0, pa0); PK4(p0, 8, pa1);
#undef PK4
#pragma unroll
        for (int i = 0; i < 8; ++i) { const int row = 4 * i + srow; *(bf16x8*)(Vw + v_st(row, scol)) = pack8(st[2 * i], st[2 * i + 1]); }
        if (__any(alpha < 1.f)) { if (hi == 0) wsf[r32] = alpha; asm volatile("s_waitcnt lgkmcnt(0)" ::: "memory");
#pragma unroll
            for (int d_ = 0; d_ < 4; ++d_)
#pragma unroll
                for (int r = 0; r < 16; ++r) o[d_][r] *= wsf[crow(r, hi)]; }
        asm volatile("s_waitcnt lgkmcnt(0)" ::: "memory"); SBAR();
#define TRRD(dst, off) asm volatile("ds_read_b64_tr_b16 %0, %1 offset:%2" : "=&v"(dst) : "v"(vb0), "i"(off) : "memory")
#define PV_D0(d0) do { s16x4 l0, l1, h0, h1; constexpr int b_ = v_rd_off(d0, 0, 0);                                        \
        TRRD(l0, b_); TRRD(h0, b_ + 2048); TRRD(l1, b_ + 4096); TRRD(h1, b_ + 6144);                                       \
        asm volatile("s_waitcnt lgkmcnt(0)" ::: "memory"); SBAR();                                                         \
        o[d0] = __builtin_amdgcn_mfma_f32_32x32x16_bf16(pa0, (bf16x8){l0[0], l0[1], l0[2], l0[3], h0[0], h0[1], h0[2], h0[3]}, o[d0], 0, 0, 0);   \
        o[d0] = __builtin_amdgcn_mfma_f32_32x32x16_bf16(pa1, (bf16x8){l1[0], l1[1], l1[2], l1[3], h1[0], h1[1], h1[2], h1[3]}, o[d0], 0, 0, 0); } while (0)
        PV_D0(0); PV_D0(1); PV_D0(2); PV_D0(3);
#undef PV_D0
#undef TRRD
        asm volatile("s_waitcnt lgkmcnt(0)" ::: "memory"); SBAR();
    }
    __syncthreads();
    { float* ow = (float*)(lds + wid * 16384);
#pragma unroll
      for (int d0 = 0; d0 < 4; ++d0)
#pragma unroll
          for (int r = 0; r < 16; ++r) ow[(d0 * 16 + r) * 64 + lane] = o[d0][r];
      if (hi == 0) { ml[wid * 64 + r32] = m_reg; ml[wid * 64 + 32 + r32] = l_reg; } }
    __syncthreads();
    { const int d0 = wid >> 1, rbase = (wid & 1) * 8;
#pragma unroll
      for (int rr = 0; rr < 8; ++rr) { const int r = rbase + rr, q = crow(r, hi);
          float mstar = ml[q];
#pragma unroll
          for (int sw = 1; sw < 8; ++sw) mstar = fmaxf(mstar, ml[sw * 64 + q]);
          float num = 0.f, den = 0.f;
#pragma unroll
          for (int sw = 0; sw < 8; ++sw) { const float f = __builtin_amdgcn_exp2f((ml[sw * 64 + q] - mstar) * C2);
              den += f * ml[sw * 64 + 32 + q]; num += f * ((const float*)(lds + sw * 16384))[(d0 * 16 + r) * 64 + lane]; }
          const unsigned w8 = o_quad_fp8(num * __builtin_amdgcn_rcpf(den));
          if ((r32 & 3) == 0) *(unsigned*)((char*)O + (size_t)q * LDR + d0 * 32 + r32) = w8; } }
    __syncthreads();
}
#undef VMW
#undef VMWN
#undef SLOAD_H
#undef SWRITE_HK
#undef SWRITE_HV
#undef SWRITE_H
#undef SLOAD_F
#undef SWRITE_KF
#undef SWRITE_VF
#undef SBAR
}

#define XB_TMO      128
#define XB_XCNT(j)  (256  + 64 * (j))
#define XB_XSUB(j)  (1280 + 64 * (j))
#define XB_XGEN(j)  (2304 + 64 * (j))
#define XB_TOP      3328
#define XB_TOPGEN   3392
#define XCD_BAR_WORDS 3456
#define XB_SPIN_CAP (1u << 18)
__device__ __forceinline__ unsigned xb_ld(unsigned* p)              { return __hip_atomic_load(p, __ATOMIC_RELAXED, __HIP_MEMORY_SCOPE_AGENT); }
__device__ __forceinline__ unsigned xb_add(unsigned* p, unsigned v) { return __hip_atomic_fetch_add(p, v, __ATOMIC_RELAXED, __HIP_MEMORY_SCOPE_AGENT); }
__device__ __forceinline__ unsigned xb_xcc_id() { return (unsigned)__builtin_amdgcn_s_getreg((3 << 11) | 20) & 0xFu; }
#define XB_SPIN(cond, bar) do { unsigned _sp = 0; while (cond) { __builtin_amdgcn_s_sleep(1); \
    if ((++_sp & 255u) == 0u) { if (xb_ld(&(bar)[XB_TMO])) break; if (_sp > XB_SPIN_CAP) { atomicAdd(&(bar)[XB_TMO], 1u); break; } } } } while (0)
struct XcdBarrier { unsigned* bar; unsigned x; volatile LAS unsigned* st; };
__device__ __forceinline__ XcdBarrier xcd_barrier_post(unsigned* bar, volatile LAS unsigned* st, const int wid) {
    XcdBarrier b; b.bar = bar; b.x = xb_xcc_id(); b.st = st;
    if (wid == 0 && lane_id() == 0) (void)xb_add(&bar[XB_XCNT(b.x)], 1u);
    return b;
}
__device__ __forceinline__ void xcd_barrier_complete(unsigned* bar, unsigned x, unsigned& nloc, unsigned& nx) {
    const unsigned G = gridDim.x * gridDim.y * gridDim.z;
    unsigned sum, cnt, mine, sp = 0u;
    for (;;) {
        sum = 0u; cnt = 0u; mine = 0u;
#pragma unroll
        for (unsigned j = 0; j < 16; ++j) { const unsigned c = xb_ld(&bar[XB_XCNT(j)]); sum += c; cnt += (c > 0u) ? 1u : 0u; mine = (j == x) ? c : mine; }
        if (sum == G) break;
        __builtin_amdgcn_s_sleep(1);
        if ((++sp & 255u) == 0u) { if (xb_ld(&bar[XB_TMO])) break; if (sp > XB_SPIN_CAP) { atomicAdd(&bar[XB_TMO], 1u); break; } }
    }
    nloc = mine > 0u ? mine : 1u; nx = cnt > 0u ? cnt : 1u;
}
__device__ __forceinline__ void xcd_barrier(const XcdBarrier& b, const int wid) {
    asm volatile("s_waitcnt vmcnt(0)" ::: "memory");
    __syncthreads();
    if (wid == 0 && lane_id() == 0) {
        unsigned* bar = b.bar;
        __builtin_amdgcn_s_waitcnt(0);
        unsigned nloc = b.st[0], nx = b.st[1];
        if (nloc == 0u) { xcd_barrier_complete(bar, b.x, nloc, nx); b.st[0] = nloc; b.st[1] = nx; }
        const unsigned old = xb_add(&bar[XB_XSUB(b.x)], 1u);
        const unsigned gen = old / nloc;
        if (old + 1u == (gen + 1u) * nloc) {
            __builtin_amdgcn_fence(__ATOMIC_RELEASE, "agent");
            asm volatile("s_waitcnt vmcnt(0)" ::: "memory");
            const unsigned og = xb_add(&bar[XB_TOP], 1u);
            const unsigned tg = og / nx;
            if (og + 1u == (tg + 1u) * nx) xb_add(&bar[XB_TOPGEN], 1u);
            else XB_SPIN(xb_ld(&bar[XB_TOPGEN]) == tg, bar);
            __builtin_amdgcn_fence(__ATOMIC_ACQUIRE, "agent");
            xb_add(&bar[XB_XGEN(b.x)], 1u);
            asm volatile("s_waitcnt vmcnt(0)" ::: "memory");
        } else {
            XB_SPIN(xb_ld(&bar[XB_XGEN(b.x)]) == gen, bar);
            __builtin_amdgcn_fence(__ATOMIC_ACQUIRE, "agent");
            asm volatile("s_waitcnt vmcnt(0)" ::: "memory");
        }
    }
    __syncthreads();
}

__device__ __forceinline__ const float* arg_in(int i) {
    const __attribute__((address_space(4))) char* kp = (const __attribute__((address_space(4))) char*)__builtin_amdgcn_kernarg_segment_ptr();
    asm volatile("" : "+s"(kp));
    return *(const float* const __attribute__((address_space(4)))*)(kp + 8 * i);
}
struct TItem { const float* src; bf16* dst; int ld, K, f8; float sc; };
__device__ __forceinline__ TItem titem_decode(int it, unsigned char* ws) {
    TItem t; const float* W; bf16* Wt; int ld, K, kb, nb, srccol, destrow;
    if (it < 10240) { W = arg_in(12); ld = NIN_SRC; K = DM; Wt = (bf16*)(ws + WS_WIN); kb = it / 320; nb = it % 320; destrow = nb * 32; srccol = destrow + (destrow >= 3072 ? 8 : 0);
        const int tl = destrow >> 8;
        if (tl < 4 || (tl >= 12 && tl < 16) || tl >= 24) { t.src = W + (size_t)(kb * 64) * ld + srccol; t.dst = (bf16*)(ws + WS_WIN8 + (size_t)destrow * K + kb * 64); t.ld = ld; t.K = K; t.f8 = 1; t.sc = WIN_SCALE; return t; } }
    else if ((it -= 10240) < 2048) { const int ob = it >= 1024; it -= ob * 1024; W = arg_in(ob ? 16 : 15); ld = DM; K = DH; Wt = (bf16*)(ws + (ob ? WS_WOB : WS_WOA)); kb = it / 64; nb = it % 64; destrow = srccol = nb * 32;
        t.src = W + (size_t)(kb * 64) * ld + srccol; t.dst = (bf16*)((unsigned char*)Wt + (size_t)destrow * K + kb * 64); t.ld = ld; t.K = K; t.f8 = 1; t.sc = WO_SCALE; return t; }
    else if ((it -= 2048) < 2048) { W = arg_in(17); ld = DM; K = DM; Wt = (bf16*)(ws + WS_WOUT); kb = it / 64; nb = it % 64; destrow = srccol = nb * 32;
        t.src = W + (size_t)(kb * 64) * ld + srccol; t.dst = (bf16*)((unsigned char*)Wt + (size_t)destrow * K + kb * 64); t.ld = ld; t.K = K; t.f8 = 1; t.sc = WOUT_SCALE; return t; }
    else if ((it -= 2048) < 5632) { W = arg_in(19); ld = DFF; K = DM; Wt = (bf16*)(ws + WS_WGU); kb = it / 176; nb = it % 176; srccol = nb * 32; destrow = (srccol >> 7) * 256 + (srccol & 127); }
    else if ((it -= 5632) < 5632) { W = arg_in(20); ld = DFF; K = DM; Wt = (bf16*)(ws + WS_WGU); kb = it / 176; nb = it % 176; srccol = nb * 32; destrow = (srccol >> 7) * 256 + 128 + (srccol & 127); }
    else { it -= 5632; W = arg_in(21); ld = DM; K = DFF; Wt = (bf16*)(ws + WS_WDN); kb = it / 64; nb = it % 64; destrow = srccol = nb * 32;
        t.src = W + (size_t)(kb * 64) * ld + srccol; t.dst = (bf16*)((unsigned char*)Wt + (size_t)destrow * K + kb * 64); t.ld = ld; t.K = K; t.f8 = 1; t.sc = WDN_SCALE; return t; }
    t.src = W + (size_t)(kb * 64) * ld + srccol; t.dst = Wt + (size_t)destrow * K + kb * 64; t.ld = ld; t.K = K; t.f8 = 0; t.sc = 1.0f; return t;
}
__device__ __forceinline__ void titem_load(const TItem& t, f32x4 (&b)[8], int lane) {
    const float* p = t.src + (size_t)(lane >> 3) * t.ld + 4 * (lane & 7);
#pragma unroll
    for (int i = 0; i < 8; ++i) b[i] = *(const f32x4*)(p + (size_t)(i * 8) * t.ld);
}
__device__ __forceinline__ void titem_store(const TItem& t, const f32x4 (&b)[8], LAS float* scr, int lane) {
#pragma unroll
    for (int i = 0; i < 8; ++i) { LAS float* w = scr + (i * 8 + (lane >> 3)) * 33 + 4 * (lane & 7); w[0] = b[i].x; w[1] = b[i].y; w[2] = b[i].z; w[3] = b[i].w; }
    LDS_WAIT(); asm volatile("" ::: "memory");
    const int c = lane & 7;
#pragma unroll
    for (int j = 0; j < 4; ++j) { const int n = (lane >> 3) + 8 * j; const LAS float* s = scr + (8 * c) * 33 + n;
        if (t.f8) { u32x2 o8; o8.x = cvt_pk4_fp8(s[0 * 33] * t.sc, s[1 * 33] * t.sc, s[2 * 33] * t.sc, s[3 * 33] * t.sc);
            o8.y = cvt_pk4_fp8(s[4 * 33] * t.sc, s[5 * 33] * t.sc, s[6 * 33] * t.sc, s[7 * 33] * t.sc);
            *(GAS u32x2*)((unsigned char*)t.dst + (size_t)n * t.K + 8 * c) = o8; continue; }
        v4u o; o.x = cvt_pk_bf16(s[0 * 33], s[1 * 33]); o.y = cvt_pk_bf16(s[2 * 33], s[3 * 33]); o.z = cvt_pk_bf16(s[4 * 33], s[5 * 33]); o.w = cvt_pk_bf16(s[6 * 33], s[7 * 33]);
        *(GAS v4u*)(t.dst + (size_t)n * t.K + 8 * c) = o; }
    LDS_WAIT(); asm volatile("" ::: "memory");
}
__device__ __forceinline__ float log_sigmoid_f(float x) { return fminf(x, 0.f) - log1pf(expf(-fabsf(x))); }

struct Args { const float* in[23]; float* out; unsigned char* ws; int ph_lo, ph_hi; };
static_assert(sizeof(Args) == 25 * 8 + 8, "Args has no padding");

__global__ void __launch_bounds__(NTHREADS, 2) fwd_kernel(Args args) {
    extern __shared__ __attribute__((aligned(16))) unsigned char lds[];
    LAS unsigned char* L = (LAS unsigned char*)lds;
    volatile LAS unsigned* MISC = (volatile LAS unsigned*)(L + MISC_OFF);
    const int wave = __builtin_amdgcn_readfirstlane(threadIdx.x >> 6);
    const int G = gridDim.x, bx = blockIdx.x;
#define TIDS() const int lane = lane_id(), tid = wave * 64 + lane; (void)tid; (void)lane
    const int vcu = (G % 8 == 0) ? (bx % 8) * (G / 8) + bx / 8 : bx;
    unsigned char* ws = args.ws; float* out = args.out;
    gu32* ctl = (gu32*)(ws + WS_CTL);
    float* mod = (float*)(ws + WS_MOD);
    float* fneg = (float*)(ws + WS_FNEG);
    bf16* Hb = (bf16*)(ws + WS_H);
    bf16* QKV = (bf16*)(ws + WS_QKV);
    bf16* ZA = (bf16*)(ws + WS_ZA); bf16* ZB = (bf16*)(ws + WS_ZB);
    bf16* ACT = (bf16*)(ws + WS_ACT);
    bf16* X1B = (bf16*)(ws + WS_ZB);
    { TIDS(); for (int u = tid; u < (LDS_BYTES - LDSCTL_OFF) / 4; u += NTHREADS) ((LAS unsigned*)(L + LDSCTL_OFF))[u] = 0u; }
    __syncthreads();
    XcdBarrier bar; bar.bar = (unsigned*)(ctl + CW_BAR); bar.x = 0; bar.st = nullptr;
    if (MK_N_LAUNCHES == 1) bar = xcd_barrier_post((unsigned*)(ctl + CW_BAR), MISC + 8, wave);
    const int lo = args.ph_lo, hi = args.ph_hi;
#define IN(k) (lo <= (k) && (k) < hi)
#define SEAM(k) do { if (IN(k) && IN((k) + 1)) xcd_barrier(bar, wave); } while (0)
    const int gw = vcu * NWAVES + wave, NGW = G * NWAVES;

    if (IN(0)) {
        TIDS();
        LAS float* scr = (LAS float*)(L + wave * 16384);
        if (wave < 3) {
            const int a = wave * 256 + (vcu & 255), cb = a % 48, kc = a / 48, k0 = kc * 128;
            if (a < 768 && vcu < 256) {
                const float* cp = arg_in(7); const float* cs = arg_in(8);
#pragma unroll
                for (int hh = 0; hh < 2; ++hh)
#pragma unroll 4
                    for (int r = 0; r < 24; ++r) { const float c = *(const float*)((const char*)((r < 8 ? cp + r * DM : cs + (r - 8) * DM) + k0 + hh * 64) + (unsigned)lane * 4u);
                        scr[(hh * 64 + lane) * 24 + r] = c * sigmoid_f(c); }
                LDS_WAIT(); asm volatile("" ::: "memory");
                f32x4 acc[24];
#pragma unroll
                for (int r = 0; r < 24; ++r) acc[r] = (f32x4){0.f, 0.f, 0.f, 0.f};
                const char* wpu = (const char*)(arg_in(9) + (size_t)k0 * NADA + cb * 256); const unsigned lo4 = (unsigned)lane * 4u;
#define ADA_LD(dst, kk) do { _Pragma("unroll") for (int q_ = 0; q_ < 4; ++q_) { const float* wp_ = (const float*)(wpu + (size_t)((kk) + q_) * (NADA * 4) + lo4); \
                    dst[q_][0] = wp_[0]; dst[q_][1] = wp_[64]; dst[q_][2] = wp_[128]; dst[q_][3] = wp_[192]; } } while (0)
#define ADA_FMA(src, kk) do { _Pragma("unroll") for (int q_ = 0; q_ < 4; ++q_) { const LAS f32x4* sp = (const LAS f32x4*)(scr + ((kk) + q_) * 24); \
                    _Pragma("unroll") for (int q = 0; q < 6; ++q) { const f32x4 s4 = sp[q]; \
                        acc[4 * q] += src[q_] * s4[0]; acc[4 * q + 1] += src[q_] * s4[1]; acc[4 * q + 2] += src[q_] * s4[2]; acc[4 * q + 3] += src[q_] * s4[3]; } } } while (0)
                f32x4 wa[4], wb[4];
                ADA_LD(wa, 0);
#pragma unroll 1
                for (int kl = 0; kl < 128; kl += 8) {
                    ADA_LD(wb, kl + 4);
                    ADA_FMA(wa, kl);
                    if (kl + 8 < 128) ADA_LD(wa, kl + 8);
                    ADA_FMA(wb, kl + 4);
                }
#undef ADA_LD
#undef ADA_FMA
                const float* ba = arg_in(10) + cb * 256 + lane;
#pragma unroll
                for (int r = 0; r < 24; ++r)
#pragma unroll
                    for (int e = 0; e < 4; ++e) unsafeAtomicAdd(mod + (size_t)r * NADA + cb * 256 + e * 64 + lane, acc[r][e] + (kc == 0 ? ba[e * 64] : 0.f));
                LDS_WAIT(); asm volatile("" ::: "memory");
            }
        }
        {
            const int nper = (31232 + G - 1) / G;
            const int jsplit = (nper * 116) / 122;
            int j, jend, jstep;
            if (wave >= 3) { j = wave - 3; jend = jsplit; jstep = 5; } else { j = jsplit + wave; jend = nper; jstep = 3; }
            for (; j < jend; j += 2 * jstep) {
                const int it0 = vcu + G * j, it1 = vcu + G * (j + jstep);
                if (it0 >= 31232) break;
                const bool two = (j + jstep < jend) && it1 < 31232;
                const TItem t0 = titem_decode(it0, ws), t1 = titem_decode(two ? it1 : it0, ws);
                f32x4 b0[8], b1[8];
                titem_load(t0, b0, lane); if (two) titem_load(t1, b1, lane);
                titem_store(t0, b0, scr, lane); if (two) titem_store(t1, b1, scr, lane);
            }
        }
    }
    SEAM(0);

#define ROW_ISBF(MODE_, m_) ((MODE_) != 0 && (m_) < MP)
#define ROW_SRC(MODE_, m_) ((MODE_) == 0 ? ((m_) < MP ? arg_in(0) + (size_t)(m_) * DM : arg_in(1) + (size_t)((m_) - MP) * DM) : out + O_YP + (size_t)(m_) * DM)
#define ROW_LOAD(MODE_, m_, vf_, vb_) do { if (ROW_ISBF(MODE_, m_)) { const GAS u32x2* xb_ = (const GAS u32x2*)(X1B + (size_t)(m_) * DM) + lane; _Pragma("unroll") for (int j = 0; j < 8; ++j) vb_[j] = xb_[64 * j]; } \
        else { const GAS f32x4* xr_ = (const GAS f32x4*)ROW_SRC(MODE_, m_) + lane; _Pragma("unroll") for (int j = 0; j < 8; ++j) vf_[j] = xr_[64 * j]; } } while (0)
#define ROW_CVT(MODE_, m_, dst_, vf_, vb_) do { if (ROW_ISBF(MODE_, m_)) { _Pragma("unroll") for (int j = 0; j < 8; ++j) dst_[j] = (f32x4){bf_lo(vb_[j].x), bf_hi(vb_[j].x), bf_lo(vb_[j].y), bf_hi(vb_[j].y)}; } \
        else { _Pragma("unroll") for (int j = 0; j < 8; ++j) dst_[j] = vf_[j]; } } while (0)
#define ROWNORM(MODE_) do { TIDS();                                                                                                         \
        const float* gv = arg_in((MODE_) == 0 ? 11 : ((MODE_) == 1 ? 18 : 22));                                                            \
        const int nrow = (NGW == 2048) ? 16 + (gw < MS ? 1 : 0) : 0;                         \
        f32x4 v[8], vn[8], ga[8], gb[8]; u32x2 vb[8]; int cur_rb = -1;                                                                      \
        if ((MODE_) == 2) { _Pragma("unroll") for (int j = 0; j < 8; ++j) ga[j] = ((const f32x4*)gv)[64 * j + lane]; }                     \
        if (nrow > 0) { ROW_LOAD(MODE_, 16 * gw, vn, vb); ROW_CVT(MODE_, 16 * gw, v, vn, vb); }                                             \
        for (int k = 0; k < nrow; ++k) { const int m = k < 16 ? 16 * gw + k : MP + gw, mnx = k + 1 < 16 ? 16 * gw + k + 1 : MP + gw;        \
            if (k + 1 < nrow) ROW_LOAD(MODE_, mnx, vn, vb);                                                                                 \
            const int rb = m < MP ? (m >> 12) : NB_P + ((m - MP) >> 5);                                                                     \
            if ((MODE_) != 2 && rb != cur_rb) { cur_rb = rb; const float* shp = mod + (size_t)rb * NADA + ((MODE_) == 0 ? 0 : 3 * DM);      \
                _Pragma("unroll") for (int j = 0; j < 8; ++j) { ga[j] = ((const f32x4*)gv)[64 * j + lane] * (1.0f + ((const f32x4*)(shp + DM))[64 * j + lane]); gb[j] = ((const f32x4*)shp)[64 * j + lane]; } } \
            if ((MODE_) != 0 && m >= MP) { const int ns_ = (MODE_) == 1 ? 8 : 11; const float* sl_ = (const float*)(ws + ((MODE_) == 1 ? WS_SLAB5 : WS_SLAB8)) + (size_t)(m - MP) * DM; \
                _Pragma("unroll") for (int j = 0; j < 8; ++j) { f32x4 t_[11]; _Pragma("unroll") for (int sp = 0; sp < 11; ++sp) if (sp < ns_) t_[sp] = ((const GAS f32x4*)(sl_ + (size_t)sp * MS * DM) + lane)[64 * j]; \
                    _Pragma("unroll") for (int sp = 0; sp < 11; ++sp) if (sp < ns_) v[j] += t_[sp]; }                                      \
                if ((MODE_) == 1) { _Pragma("unroll") for (int j = 0; j < 8; ++j) *((GAS f32x4*)(out + O_YP + (size_t)m * DM) + 64 * j + lane) = v[j]; } }   \
            float s = 0.f;                                                                                                                  \
            _Pragma("unroll") for (int j = 0; j < 8; ++j) s += (v[j].x * v[j].x + v[j].y * v[j].y) + (v[j].z * v[j].z + v[j].w * v[j].w);   \
            const float rstd = 1.0f / sqrtf(wave_sum(s) * (1.0f / DM) + RMS_EPS);                                                           \
            _Pragma("unroll") for (int j = 0; j < 8; ++j) {                                                                                 \
                if ((MODE_) == 0 && m >= MP) *((GAS f32x4*)(out + O_YP + (size_t)m * DM) + 64 * j + lane) = v[j];                          \
                if ((MODE_) != 2) { const f32x4 hv = (v[j] * rstd) * ga[j] + gb[j]; v[j] = hv;                                              \
                    u32x2 w; w.x = cvt_pk_bf16(hv.x, hv.y); w.y = cvt_pk_bf16(hv.z, hv.w);                                                  \
                    *((GAS u32x2*)(Hb + (size_t)m * DM) + 64 * j + lane) = w;                                                               \
                    if ((MODE_) == 0) *((GAS unsigned*)(ws + WS_H8 + (size_t)m * DM) + 64 * j + lane) = cvt_pk4_fp8(hv.x * H_SCALE, hv.y * H_SCALE, hv.z * H_SCALE, hv.w * H_SCALE); } \
                else { *((GAS f32x4*)(out + O_YP + (size_t)m * DM) + 64 * j + lane) = (v[j] * rstd) * ga[j]; } }                            \
            if ((MODE_) == 0) {                                                                                                             \
                float fa[8];                                                                                                                \
                _Pragma("unroll") for (int jh = 0; jh < 8; ++jh) { float a = 0.f;                                                           \
                    _Pragma("unroll") for (int j = 0; j < 8; ++j) { const f32x4 w4 = ((const LAS f32x4*)(L + jh * 8192))[64 * j + lane];    \
                        a += (v[j].x * w4.x + v[j].y * w4.y) + (v[j].z * w4.z + v[j].w * w4.w); }                                           \
                    fa[jh] = wave_sum(a); }                                                                                                 \
                float f = fa[0];                                                                                                            \
                _Pragma("unroll") for (int jh = 1; jh < 8; ++jh) f = (lane == jh) ? fa[jh] : f;                                             \
                if (lane < 8) { const float lf = log_sigmoid_f(f + arg_in(13)[lane]);                                                      \
                    if (m < MP) out[O_FLP + (size_t)m * 8 + lane] = lf; else out[O_FLS + (size_t)(m - MP) * 8 + lane] = lf; } }             \
            if (k + 1 < nrow) ROW_CVT(MODE_, mnx, v, vn, vb);                                                                               \
        } } while (0)
    if (IN(1)) for (int rep = 0; rep < NREP(1); ++rep) {
        { TIDS(); for (int k = tid; k < DM; k += NTHREADS) { const float* p = arg_in(12) + (size_t)k * NIN_SRC + 3072;
            const f32x4 a = *(const f32x4*)p, b = *(const f32x4*)(p + 4);
            LAS float* w = (LAS float*)L + k;
            w[0] = a.x; w[2048] = a.y; w[4096] = a.z; w[6144] = a.w; w[8192] = b.x; w[10240] = b.y; w[12288] = b.z; w[14336] = b.w; } }
        __syncthreads();
        ROWNORM(0);
        __syncthreads();
    }
    SEAM(1);

    if (IN(2)) for (int rep = 0; rep < NREP(2); ++rep) {
        if (bx >= 64 && bx < 256) {
            TIDS();
            const int sid = bx - 64;
            LAS float* wtot = (LAS float*)L;
            const bool smp = sid >= 64; const int bh = smp ? sid - 64 : sid, b = bh >> 3, h = bh & 7;
            const float* src = smp ? arg_in(4) + ((size_t)b * PAST) * 8 + h : out + O_FLP + ((size_t)b * SEQ) * 8 + h;
            float v[8];
#pragma unroll
            for (int j = 0; j < 8; ++j) v[j] = src[(size_t)(tid * 8 + j) * 8];
#pragma unroll
            for (int j = 1; j < 8; ++j) v[j] += v[j - 1];
            float incl = v[7];
#pragma unroll
            for (int o = 1; o < 64; o <<= 1) { const float t = __shfl_up(incl, o); if (lane >= o) incl += t; }
            if (lane == 63) wtot[wave] = incl;
            __syncthreads();
            float base = incl - v[7];
            for (int w = 0; w < wave; ++w) base += wtot[w];
            float* dst = fneg + (size_t)sid * FNEG_LD;
#pragma unroll
            for (int j = 0; j < 8; ++j) dst[tid * 8 + j] = -(base + v[j]) * att::INV_SCALE;
            if (smp && wave == 0) {
                float tot = 0.f;
                for (int w = 0; w < 8; ++w) tot += wtot[w];
                float x = lane < TS ? out[O_FLS + ((size_t)b * TS + lane) * 8 + h] : 0.f;
#pragma unroll
                for (int o = 1; o < 64; o <<= 1) { const float t = __shfl_up(x, o); if (lane >= o) x += t; }
                dst[PAST + lane] = lane < TS ? -(tot + x) * att::INV_SCALE : 0.f;
            }
            __syncthreads();
        }
        {
            pg8::Gemm g{Hb, (const bf16*)(ws + WS_WIN), nullptr, nullptr, DM};
            pg8::StaticOrder S; S.init(NMT, 16, G, bx, 0, DM / 64);
            pg8::EpiInProj<false> E{QKV, ZA, ZB, out};
            pg8::gemm_phase<pg8::EpiInProj<false>>(L, g, S, E, wave);
        }
        {
            pg8::Gemm g{(const bf16*)(ws + WS_H8), (const bf16*)(ws + WS_WIN8), nullptr, nullptr, DM};
            pg8::StaticOrder S; S.init(NMT, 24, G, bx, 0, DM / 128); S.skew = 32; S.nfull = 11;
            pg8::EpiInProj<true> E{QKV, ZA, ZB, out};
            pg8::gemm_phase<pg8::EpiInProj<true>, true, true>(L, g, S, E, wave);
        }
    }
    SEAM(2);

    if (IN(3)) for (int rep = 0; rep < NREP(3); ++rep) {
        char* al = (char*)lds;
        LAS float* FL = (LAS float*)(L + att::OFF_FL);
        LAS float* TB = (LAS float*)(L + att::OFF_TB);
        volatile LAS int* QW = (volatile LAS int*)(L + att::OFF_QW);
        bf16* QAb = QKV; bf16* KAb = QKV + QKV_STRIDE; bf16* VAb = QKV + 2 * QKV_STRIDE; bf16* QBb = QKV + 3 * QKV_STRIDE; bf16* KBb = QKV + 4 * QKV_STRIDE; bf16* VBb = QKV + 5 * QKV_STRIDE;
        unsigned char* OA8 = (unsigned char*)Hb; unsigned char* OB8 = OA8 + QKV_STRIDE_B;
        const float* rel = arg_in(14);
        att::Seam S;
        if (vcu < 256) {
            const int u = vcu >> 1, b = u >> 3, h = u & 7;
            if ((vcu & 1) == 0) {
                att::foxs_unit(QAb + (size_t)(MP + b * TS) * DH + h * HD, (bf16*)(OA8 + (size_t)(MP + b * TS) * DH + h * HD),
                               arg_in(2) + ((size_t)b * PAST * NH + h) * HD, arg_in(3) + ((size_t)b * PAST * NH + h) * HD,
                               out + O_FKS + (size_t)(b * TS) * DH + h * HD, out + O_FVS + (size_t)(b * TS) * DH + h * HD,
                               fneg + (size_t)(64 + u) * FNEG_LD, al, wave);
            } else {
                const float t256 = rel[256 * NH + h];
                { TIDS(); for (int i = tid; i < 257; i += NTHREADS) TB[i] = (rel[i * NH + h] - t256) * att::INV_SCALE; }
                att::Job J; J.Q = QBb + (size_t)(MP + b * TS) * DH + h * HD; J.O = (bf16*)(OB8 + (size_t)(MP + b * TS) * DH + h * HD);
                J.K = arg_in(5) + ((size_t)b * LBAND * NH + h) * HD; J.V = arg_in(6) + ((size_t)b * LBAND * NH + h) * HD;
                J.Kn = out + O_BKS + (size_t)(b * TS) * DH + h * HD; J.Vn = out + O_BVS + (size_t)(b * TS) * DH + h * HD;
                J.P0 = LBAND; J.j_lo = 0; J.j_hi = LBAND / 64 + 1;
                att::attn_prime<att::BANDS>(J, al, S, wave);
                att::attn_block<att::BANDS>(J, J, al, S, wave);
            }
        }
        __syncthreads();
        if (vcu < 256) {
            const int bh = vcu >> 2, gq = vcu & 3, b = bh >> 3, h = bh & 7;
            const float* fsrc = fneg + (size_t)bh * FNEG_LD;
            const size_t hb = (size_t)(b * SEQ) * DH + h * HD;
            LAS float* red = (LAS float*)(L + att::OFF_QW + 64);
            float kmax2, qmax2[4];
            { TIDS(); for (int i = tid; i < SEQ / 4; i += NTHREADS) ((LAS f32x4*)FL)[i] = ((const f32x4*)fsrc)[i];
              const int sub = lane & 15, ro = tid >> 4;
#define ROWSS(p_) ({ const u32x4 w_ = *(const u32x4*)(p_); float s_ = bf_lo(w_.x) * bf_lo(w_.x) + bf_hi(w_.x) * bf_hi(w_.x); s_ += bf_lo(w_.y) * bf_lo(w_.y) + bf_hi(w_.y) * bf_hi(w_.y); \
                  s_ += bf_lo(w_.z) * bf_lo(w_.z) + bf_hi(w_.z) * bf_hi(w_.z); s_ += bf_lo(w_.w) * bf_lo(w_.w) + bf_hi(w_.w) * bf_hi(w_.w); \
                  s_ += __builtin_bit_cast(float, __builtin_amdgcn_update_dpp(0, __builtin_bit_cast(int, s_), 0xB1, 0xF, 0xF, true));      \
                  s_ += __builtin_bit_cast(float, __builtin_amdgcn_update_dpp(0, __builtin_bit_cast(int, s_), 0x4E, 0xF, 0xF, true));      \
                  s_ += __builtin_bit_cast(float, __builtin_amdgcn_update_dpp(0, __builtin_bit_cast(int, s_), 0x141, 0xF, 0xF, true));     \
                  s_ += __builtin_bit_cast(float, __builtin_amdgcn_update_dpp(0, __builtin_bit_cast(int, s_), 0x140, 0xF, 0xF, true));     \
                  s_; })
#define WGMAX(v_) ({ float m_ = (v_); _Pragma("unroll") for (int o_ = 1; o_ < 64; o_ <<= 1) m_ = fmaxf(m_, __shfl_xor(m_, o_)); if (lane == 0) red[wave] = m_; __syncthreads(); \
                  float r_ = red[0]; _Pragma("unroll") for (int w_ = 1; w_ < 8; ++w_) r_ = fmaxf(r_, red[w_]); __syncthreads(); r_; })
              float km = 0.f; const bf16* Kp = KAb + hb + sub * 8;
#pragma unroll 8
              for (int sr_ = ro; sr_ < SEQ; sr_ += 32) km = fmaxf(km, ROWSS(Kp + (size_t)sr_ * DH));
              kmax2 = WGMAX(km);
#pragma unroll
              for (int i = 0; i < 4; ++i) { const int qb = (i == 0) ? 15 - gq : (i == 1) ? 8 + gq : (i == 2) ? 7 - gq : gq; float qm = 0.f; const bf16* Qp = QAb + hb + (size_t)(qb * 256) * DH + sub * 8;
#pragma unroll
                  for (int sr_ = ro; sr_ < 256; sr_ += 32) qm = fmaxf(qm, ROWSS(Qp + (size_t)sr_ * DH));
                  qmax2[i] = WGMAX(qm); }
#undef ROWSS
#undef WGMAX
            }
            att::Job J[4];
#pragma unroll
            for (int i = 0; i < 4; ++i) { const int qb = (i == 0) ? 15 - gq : (i == 1) ? 8 + gq : (i == 2) ? 7 - gq : gq;
                const float thr = 32.0f * att::INV_SCALE + 2.0f * sqrtf(qmax2[i] * kmax2) * 1.001f + 1.0f;
                const float f0 = FL[qb * 256]; int jl = 0;
                for (int j = 0; j < 4 * qb; ++j) jl += (FL[64 * j + 63] - f0 <= -thr) ? 1 : 0;
                jl = __builtin_amdgcn_readfirstlane(jl);
                J[i].Q = QAb + hb + (size_t)(qb * 256) * DH; J[i].O = (bf16*)(OA8 + hb + (size_t)(qb * 256) * DH); J[i].K = KAb + hb; J[i].V = VAb + hb; J[i].Kn = nullptr; J[i].Vn = nullptr;
                J[i].P0 = qb * 256; J[i].j_lo = jl; J[i].j_hi = 4 * (qb + 1); }
            att::attn_prime<att::FOXP>(J[0], al, S, wave);
            att::attn_block<att::FOXP>(J[0], J[1], al, S, wave);
            att::attn_block<att::FOXP>(J[1], J[2], al, S, wave);
            att::attn_block<att::FOXP>(J[2], J[3], al, S, wave);
            att::attn_block<att::FOXP>(J[3], J[3], al, S, wave);
        }
        __syncthreads();
#define BJOB(J_, hb_, g_) do { (J_).Q = QBb + (hb_) + (size_t)((g_) * 256) * DH; (J_).O = (bf16*)(OB8 + (hb_) + (size_t)((g_) * 256) * DH); (J_).K = KBb + (hb_); (J_).V = VBb + (hb_); \
        (J_).Kn = nullptr; (J_).Vn = nullptr; (J_).P0 = (g_) * 256; (J_).j_lo = (4 * (g_) - 8) > 0 ? 4 * (g_) - 8 : 0; (J_).j_hi = 4 * (g_) + 4; } while (0)
        if (vcu < 256) {
            const int bh = vcu >> 2, gsel = vcu & 3, b = bh >> 3, h = bh & 7;
            const int g0 = gsel == 0 ? 7 : gsel == 1 ? 2 : gsel == 2 ? 14 : 9, nb = (gsel & 1) ? 5 : 2;
            const float t256 = rel[256 * NH + h];
            { TIDS(); for (int i = tid; i < 257; i += NTHREADS) TB[i] = (rel[i * NH + h] - t256) * att::INV_SCALE; }
            const size_t hb = (size_t)(b * SEQ) * DH + h * HD;
            att::Job J, Jn; BJOB(J, hb, g0);
            att::attn_prime<att::BANDP>(J, al, S, wave);
            for (int k = 0; k < nb; ++k) { const int gn = g0 + (k + 1 < nb ? k + 1 : k); BJOB(Jn, hb, gn);
                att::attn_block<att::BANDP>(J, Jn, al, S, wave); J = Jn; }
        }
        __syncthreads();
        for (;;) {
            if (wave == 0 && lane_id() == 0) QW[0] = (int)__hip_atomic_fetch_add((unsigned*)(ctl + CW_Q + 64 * rep), 1u, RLX_AGENT);
            __syncthreads();
            const int v = QW[0];
            if (v >= 128) break;
            const int gq = 1 - (v >> 6), bh = v & 63, b = bh >> 3, h = bh & 7;
            const float t256 = rel[256 * NH + h];
            { TIDS(); for (int i = tid; i < 257; i += NTHREADS) TB[i] = (rel[i * NH + h] - t256) * att::INV_SCALE; }
            const size_t hb = (size_t)(b * SEQ) * DH + h * HD;
            att::Job J; BJOB(J, hb, gq);
            att::attn_prime<att::BANDP>(J, al, S, wave);
            att::attn_block<att::BANDP>(J, J, al, S, wave);
        }
        __syncthreads();
#undef BJOB
    }
    SEAM(3);

    if (IN(4)) {
        pg8::Gemm g{Hb, (const bf16*)(ws + WS_WOA), Hb + QKV_STRIDE, (const bf16*)(ws + WS_WOB), DH};
        pg8::StaticOrder S; S.init(MP / 256, DM / 256, G, bx, 1, DH / 128, 64, 4, 4, MP / 256, 1);
        pg8::EpiMerge E{ZA, ZB, (float*)(ws + WS_SLAB4), ws + WS_M8};
        pg8::gemm_phase<pg8::EpiMerge, true, true>(L, g, S, E, wave);
    }
    SEAM(4);
    if (IN(5)) {
        TIDS();
        if (gw < MS) { const float* sl = (const float*)(ws + WS_SLAB4) + (size_t)gw * DM;
#pragma unroll
            for (int j = 0; j < 8; ++j) { f32x4 t = ((const GAS f32x4*)sl + lane)[64 * j];
#pragma unroll
                for (int sp = 1; sp < 4; ++sp) t += ((const GAS f32x4*)(sl + (size_t)sp * MS * DM) + lane)[64 * j];
                *((GAS unsigned*)(ws + WS_M8 + (size_t)(MP + gw) * DM) + 64 * j + lane) = cvt_pk4_fp8(t.x * M_SCALE, t.y * M_SCALE, t.z * M_SCALE, t.w * M_SCALE); } }
        if (IN(4)) xcd_barrier(bar, wave);
    }
    if (IN(5)) for (int rep = 0; rep < NREP(5); ++rep) {
        pg8::Gemm g{(const bf16*)(ws + WS_M8), (const bf16*)(ws + WS_WOUT), nullptr, nullptr, DM};
        pg8::StaticOrder S; S.init(MP / 256, DM / 256, G, bx, 0, DM / 128, 128, 8, 2, MP / 256);
        pg8::EpiResid<true> E{arg_in(0), X1B, mod + 2 * DM, (float*)(ws + WS_SLAB5)};
        pg8::gemm_phase<pg8::EpiResid<true>, true, true>(L, g, S, E, wave);
    }
    SEAM(5);
    if (IN(6)) for (int rep = 0; rep < NREP(6); ++rep) { ROWNORM(1); }
    SEAM(6);
    if (IN(7)) for (int rep = 0; rep < NREP(7); ++rep) {
        pg8::Gemm g{Hb, (const bf16*)(ws + WS_WGU), nullptr, nullptr, DM};
        pg8::StaticOrder S; S.init(NMT, 2 * DFF / 256, G, bx, 0, DM / 64);
        pg8::EpiSwiglu E{ACT};
        pg8::gemm_phase<pg8::EpiSwiglu>(L, g, S, E, wave);
    }
    SEAM(7);
    if (IN(8)) {
        pg8::Gemm g{ACT, (const bf16*)(ws + WS_WDN), nullptr, nullptr, DFF};
        pg8::StaticOrder S; S.init(MP / 256, DM / 256, G, bx, 0, DFF / 128, 176, 11, 4, MP / 256);
        pg8::EpiResid<false> E{arg_in(0), X1B, mod + 5 * DM, (float*)(ws + WS_SLAB8)};
        pg8::gemm_phase<pg8::EpiResid<false>, true, true>(L, g, S, E, wave);
    }
    SEAM(8);
    if (IN(9)) { ROWNORM(2); }
#undef IN
#undef SEAM
#undef ROWNORM
#undef ROW_SRC
#undef ROW_ISBF
#undef ROW_LOAD
#undef ROW_CVT
}

extern "C" void kernel_launch(void* const* d_in, const int* in_sizes, int n_in, void* d_out, int out_size, void* d_ws, size_t ws_size, hipStream_t stream) {
    static int grid = 0;
    if (grid == 0) {
        if (n_in != 23 || in_sizes[0] != MP * DM || (size_t)out_size != O_TOTAL || ws_size < WS_END) {
            fprintf(stderr, "kernel_launch: shape mismatch (n_in %d, in0 %d, out %d, ws %zu); nothing launched\n", n_in, n_in > 0 ? in_sizes[0] : -1, out_size, ws_size); grid = -1; return; }
        int dev = 0, cus = 0, per_cu = 0;
        if (hipGetDevice(&dev) != hipSuccess || hipDeviceGetAttribute(&cus, hipDeviceAttributeMultiprocessorCount, dev) != hipSuccess) { fprintf(stderr, "kernel_launch: device query failed\n"); grid = -1; return; }
        if (hipFuncSetAttribute((const void*)fwd_kernel, hipFuncAttributeMaxDynamicSharedMemorySize, LDS_BYTES) != hipSuccess) { fprintf(stderr, "kernel_launch: hipFuncSetAttribute failed\n"); grid = -1; return; }
        if (hipOccupancyMaxActiveBlocksPerMultiprocessor(&per_cu, (const void*)fwd_kernel, NTHREADS, LDS_BYTES) != hipSuccess || per_cu < 1)
            fprintf(stderr, "kernel_launch: note: occupancy query reports %d workgroups per CU\n", per_cu);
        (void)hipGetLastError();
        grid = cus < 256 ? cus : 256;
    }
    if (grid < 0) return;
    Args a{};
    for (int i = 0; i < 23; ++i) a.in[i] = (const float*)d_in[i];
    a.out = (float*)d_out; a.ws = (unsigned char*)d_ws;
    if (PROBE_PREFIX >= 0) { (void)hipMemsetAsync((char*)d_ws + WS_CTL, 0, ZERO_BYTES, stream); a.ph_lo = 0; a.ph_hi = PROBE_PREFIX + 1;
        hipLaunchKernelGGL(fwd_kernel, dim3(grid), dim3(NTHREADS), LDS_BYTES, stream, a); }
    if (hipMemsetAsync((char*)d_ws + WS_CTL, 0, ZERO_BYTES, stream) != hipSuccess) { fprintf(stderr, "kernel_launch: memset failed\n"); return; }
    if (MK_N_LAUNCHES == 1) { a.ph_lo = 0; a.ph_hi = 10; hipLaunchKernelGGL(fwd_kernel, dim3(grid), dim3(NTHREADS), LDS_BYTES, stream, a); }
    else for (int p = 0; p < 10; ++p) { a.ph_lo = p; a.ph_hi = p + 1; hipLaunchKernelGGL(fwd_kernel, dim3(grid), dim3(NTHREADS), LDS_BYTES, stream, a); }
    const hipError_t le = hipPeekAtLastError();
    if (le != hipSuccess) fprintf(stderr, "kernel_launch: launch failed: %s\n", hipGetErrorName(le));
}
```
